# Optimizing an MI355X kernel written in HIP

```python
import math
import jax, jax.numpy as jnp
from jax import lax
import numpy as np

D_MODEL = 1024
BATCH = 16
SEQ = 2048
DEPTH = 4

CTX_LEN = 256
GRID_W = 64
HEAD_DIM = 64
Q_BLOCK = 128
ROPE_THETA = 10000.0
ROPE_HALF = HEAD_DIM // 4
ATTN_SCALE = HEAD_DIM ** -0.5
A_HEADS = 8
A_KV_HEADS = 2
A_GROUP = A_HEADS // A_KV_HEADS
A_WIDTH = A_HEADS * HEAD_DIM
B_WIDTH = D_MODEL // 2
CONV_W = 3
C_HEADS = 4
C_WIDTH = C_HEADS * 2 * HEAD_DIM
SUBLN_DIM = 2 * HEAD_DIM
N_BRANCH = 3
EPS = 1e-6
PROJ_WIDTHS = (
    A_WIDTH, A_KV_HEADS * HEAD_DIM, A_KV_HEADS * HEAD_DIM, A_WIDTH,
    B_WIDTH, B_WIDTH, B_WIDTH, B_WIDTH,
    C_WIDTH, C_WIDTH, C_WIDTH, C_WIDTH,
    N_BRANCH * D_MODEL,
)
PROJ_TOTAL = sum(PROJ_WIDTHS)

kernel_name = "hybrid_gqa_shortconv_diffattn_prefix_dit"


def rmsnorm(x, g=None):
    xf = x.astype(jnp.float32)
    y = xf * lax.rsqrt(jnp.mean(xf * xf, axis=-1, keepdims=True) + EPS)
    if g is not None:
        y = y * g.astype(jnp.float32)
    return y.astype(x.dtype)


def split_proj(p):
    idx = np.cumsum(PROJ_WIDTHS)[:-1].tolist()
    return jnp.split(p, idx, axis=-1)


def axial_rope(x, cos, sin):
    shp = x.shape
    xr = x.astype(jnp.float32).reshape(*shp[:-1], 2, 2, ROPE_HALF)
    x1, x2 = xr[..., 0, :], xr[..., 1, :]
    bshape = (shp[1],) + (1,) * (x.ndim - 3) + (2, ROPE_HALF)
    cs, sn = cos.reshape(bshape), sin.reshape(bshape)
    out = jnp.stack([x1 * cs - x2 * sn, x2 * cs + x1 * sn], axis=-2)
    return out.reshape(shp).astype(x.dtype)


def sweep_query_blocks(fn, q):
    b, s = q.shape[:2]
    nb = s // Q_BLOCK
    qb = jnp.moveaxis(q.reshape(b, nb, Q_BLOCK, *q.shape[2:]), 1, 0)
    out = lax.map(fn, qb)
    return jnp.moveaxis(out, 0, 1).reshape(b, s, *out.shape[3:])


def gqa(q, k, v):
    s = jnp.einsum('bqkgd,bskd->bkgqs', q, k).astype(jnp.float32) * ATTN_SCALE
    p = jax.nn.softmax(s, axis=-1)
    return jnp.einsum('bkgqs,bskd->bqkgd', p.astype(v.dtype), v)


def diff_attention(q, k, v, lam):
    s = jnp.einsum('bqhmd,bshmd->bhmqs', q, k).astype(jnp.float32) * ATTN_SCALE
    p = jax.nn.softmax(s, axis=-1)
    a = p[:, :, 0] - lam * p[:, :, 1]
    return jnp.einsum('bhqs,bshe->bqhe', a.astype(v.dtype), v)


def short_conv(z, w):
    zp = jnp.pad(z, ((0, 0), (1, 1), (0, 0)))
    return w[0] * zp[:, :-2] + w[1] * zp[:, 1:-1] + w[2] * zp[:, 2:]


def merge_branches(ya, yb, yc, ag, bg, cg, mg, wa, wb, wc, wo):
    ga, gb, gc = jnp.split(jax.nn.sigmoid(mg), N_BRANCH, axis=-1)
    merged = (ga * ((ya * jax.nn.silu(ag)) @ wa)
              + gb * ((yb * jax.nn.silu(bg)) @ wb)
              + gc * ((yc * jax.nn.silu(cg)) @ wc))
    return merged @ wo


def setup_inputs(seed: int = 0) -> dict:
    key = jax.random.key(seed)
    ks = jax.random.split(key, 20)
    f32 = jnp.float32
    nrm = lambda k, shp, s: (jax.random.normal(k, shp, f32) * s).astype(f32)
    return {
        "x": nrm(ks[0], (BATCH, SEQ, D_MODEL), 1.0),
        "c": nrm(ks[1], (BATCH, D_MODEL), 1.0),
        "ctx": nrm(ks[2], (BATCH, CTX_LEN, D_MODEL), 1.0),
        "c_ctx": nrm(ks[3], (D_MODEL,), 1.0),
        "w_mod": nrm(ks[4], (DEPTH, D_MODEL, 3 * D_MODEL), 0.5 * D_MODEL ** -0.5),
        "b_mod": nrm(ks[5], (DEPTH, 3 * D_MODEL), 0.02),
        "w_in": nrm(ks[6], (DEPTH, D_MODEL, PROJ_TOTAL), D_MODEL ** -0.5),
        "q_norm_a": 1.0 + nrm(ks[7], (DEPTH, HEAD_DIM), 0.02),
        "k_norm_a": 1.0 + nrm(ks[8], (DEPTH, HEAD_DIM), 0.02),
        "conv_w_b": nrm(ks[9], (DEPTH, CONV_W, B_WIDTH), CONV_W ** -0.5),
        "lam_q1": nrm(ks[10], (DEPTH, HEAD_DIM), 0.1),
        "lam_k1": nrm(ks[11], (DEPTH, HEAD_DIM), 0.1),
        "lam_q2": nrm(ks[12], (DEPTH, HEAD_DIM), 0.1),
        "lam_k2": nrm(ks[13], (DEPTH, HEAD_DIM), 0.1),
        "subln_c": 1.0 + nrm(ks[14], (DEPTH, SUBLN_DIM), 0.02),
        "w_branch_a": nrm(ks[15], (DEPTH, A_WIDTH, D_MODEL), A_WIDTH ** -0.5),
        "w_branch_b": nrm(ks[16], (DEPTH, B_WIDTH, D_MODEL), B_WIDTH ** -0.5),
        "w_branch_c": nrm(ks[17], (DEPTH, C_WIDTH, D_MODEL), C_WIDTH ** -0.5),
        "w_out": nrm(ks[18], (DEPTH, D_MODEL, D_MODEL), D_MODEL ** -0.5),
        "final_norm": 1.0 + nrm(ks[19], (D_MODEL,), 0.02),
    }


def reference(x, c, ctx, c_ctx, w_mod, b_mod, w_in, q_norm_a, k_norm_a, conv_w_b,
              lam_q1, lam_k1, lam_q2, lam_k2, subln_c, w_branch_a, w_branch_b,
              w_branch_c, w_out, final_norm):
    B, S, D = x.shape
    L = ctx.shape[1]
    ROWS = S // GRID_W
    rows = jnp.repeat(jnp.arange(ROWS), GRID_W).astype(jnp.float32)
    cols = jnp.tile(jnp.arange(GRID_W), ROWS).astype(jnp.float32)
    inv_freq = ROPE_THETA ** (-jnp.arange(ROPE_HALF, dtype=jnp.float32) / ROPE_HALF)
    ang = jnp.stack([rows[:, None] * inv_freq, cols[:, None] * inv_freq], axis=1)
    cos, sin = jnp.cos(ang), jnp.sin(ang)

    for i in range(DEPTH):
        last = i == DEPTH - 1
        lambda_init = 0.8 - 0.6 * math.exp(-0.3 * i)
        shift, scale, gate = jnp.split(jax.nn.silu(c) @ w_mod[i] + b_mod[i], 3, axis=-1)
        shift_c, scale_c, gate_c = jnp.split(jax.nn.silu(c_ctx) @ w_mod[i] + b_mod[i], 3, axis=-1)
        hx = rmsnorm(x) * (1 + scale[:, None]) + shift[:, None]
        hc = rmsnorm(ctx) * (1 + scale_c) + shift_c
        (aq, ak, av, ag, bh, bb, bc, bg, cq, ck, cv, cg, mg) = split_proj(hx @ w_in[i])
        (aq_c, ak_c, av_c, ag_c, bh_c, bb_c, bc_c, bg_c,
         cq_c, ck_c, cv_c, cg_c, mg_c) = split_proj(hc @ w_in[i])

        qa = axial_rope(rmsnorm(aq.reshape(B, S, A_HEADS, HEAD_DIM), q_norm_a[i]), cos, sin)
        ka = axial_rope(rmsnorm(ak.reshape(B, S, A_KV_HEADS, HEAD_DIM), k_norm_a[i]), cos, sin)
        va = av.reshape(B, S, A_KV_HEADS, HEAD_DIM)
        ka_c = rmsnorm(ak_c.reshape(B, L, A_KV_HEADS, HEAD_DIM), k_norm_a[i])
        va_c = av_c.reshape(B, L, A_KV_HEADS, HEAD_DIM)
        ka_all = jnp.concatenate([ka_c, ka], axis=1)
        va_all = jnp.concatenate([va_c, va], axis=1)
        ya = sweep_query_blocks(lambda qb: gqa(qb, ka_all, va_all),
                                qa.reshape(B, S, A_KV_HEADS, A_GROUP, HEAD_DIM)).reshape(B, S, A_WIDTH)

        yb = bb * short_conv(bc * bh, conv_w_b[i])

        lam = (jnp.exp(jnp.sum(lam_q1[i].astype(jnp.float32) * lam_k1[i].astype(jnp.float32)))
               - jnp.exp(jnp.sum(lam_q2[i].astype(jnp.float32) * lam_k2[i].astype(jnp.float32)))
               + lambda_init)
        qc = axial_rope(cq.reshape(B, S, C_HEADS, 2, HEAD_DIM), cos, sin)
        kc = axial_rope(ck.reshape(B, S, C_HEADS, 2, HEAD_DIM), cos, sin)
        vc = cv.reshape(B, S, C_HEADS, SUBLN_DIM)
        kc_c = ck_c.reshape(B, L, C_HEADS, 2, HEAD_DIM)
        vc_c = cv_c.reshape(B, L, C_HEADS, SUBLN_DIM)
        kc_all = jnp.concatenate([kc_c, kc], axis=1)
        vc_all = jnp.concatenate([vc_c, vc], axis=1)
        yc = sweep_query_blocks(lambda qb: diff_attention(qb, kc_all, vc_all, lam), qc)
        yc = (rmsnorm(yc, subln_c[i]) * (1 - lambda_init)).reshape(B, S, C_WIDTH)

        out = merge_branches(ya, yb, yc, ag, bg, cg, mg,
                             w_branch_a[i], w_branch_b[i], w_branch_c[i], w_out[i])

        if not last:
            qa_c = rmsnorm(aq_c.reshape(B, L, A_HEADS, HEAD_DIM), q_norm_a[i])
            ya_c = gqa(qa_c.reshape(B, L, A_KV_HEADS, A_GROUP, HEAD_DIM), ka_c, va_c).reshape(B, L, A_WIDTH)
            yb_c = bb_c * short_conv(bc_c * bh_c, conv_w_b[i])
            yc_c = diff_attention(cq_c.reshape(B, L, C_HEADS, 2, HEAD_DIM), kc_c, vc_c, lam)
            yc_c = (rmsnorm(yc_c, subln_c[i]) * (1 - lambda_init)).reshape(B, L, C_WIDTH)
            out_c = merge_branches(ya_c, yb_c, yc_c, ag_c, bg_c, cg_c, mg_c,
                                   w_branch_a[i], w_branch_b[i], w_branch_c[i], w_out[i])
            ctx = ctx + gate_c * out_c

        x = x + gate[:, None] * out

    return rmsnorm(x, final_norm)
```

```cpp
#include <hip/hip_runtime.h>
#include <hip/hip_cooperative_groups.h>
#include <cstdio>
#include <cstdint>
namespace cg = cooperative_groups;
namespace pg8 {
#define PG8_LAS __attribute__((address_space(3)))
typedef unsigned short bf16_t;
typedef short bf16x8 __attribute__((ext_vector_type(8)));
typedef float f32x4 __attribute__((ext_vector_type(4)));
typedef unsigned u32x4 __attribute__((ext_vector_type(4)));
constexpr int BM = 256, BK = 64, HALF = 128, HTB = HALF * BK * 2  , STAGE_BYTES = 8 * HTB, NXCD = 8, WGM = 8;

__host__ __device__ __forceinline__ int lds_byte(int r, int c) { const int st = (r >> 4) * 2 + (c >> 5), rr = r & 15, cc = c & 31, ob = rr * 64 + cc * 2; return st * 1024 + (ob ^ (((ob >> 9) & 1) << 5)); }
__host__ __device__ __forceinline__ void stage_rc(int b, int& R, int& C) { const int st = b / 1024, sb = b % 1024, swz = sb ^ (((sb >> 9) & 1) << 5); R = (st >> 1) * 16 + swz / 64; C = (st & 1) * 32 + (swz % 64) / 2; }
__host__ __device__ __forceinline__ int perm32(int rho) { const int n = rho >> 4, i = rho & 15; return 8 * (i >> 2) + 4 * n + (i & 3); }

struct Unit { int pm, pn, kb, br; };
struct Gemm { const bf16_t* A; const bf16_t* Bt; int M, N, K, nt; };

struct StaticOrder {
    int nM, nN, nwg, G, c;
    __host__ __device__ void init(int M, int N, int G_, int c_) { nM = M / BM; nN = N / BM; nwg = nM * nN; G = G_; c = c_; }
    __host__ __device__ bool next(int i, Unit& u) const {
        const long L = (long)i * G + c; if (L >= nwg) return false;
        int wgid = (int)L; { const int q = nwg / NXCD, r = nwg % NXCD, xcd = wgid % NXCD, off = wgid / NXCD; wgid = (xcd < r ? xcd * (q + 1) : r * (q + 1) + (xcd - r) * q) + off; }
        const int nig = WGM * nN, gid = wgid / nig, fm = gid * WGM, gsz = (nM - fm) < WGM ? (nM - fm) : WGM;
        u.pm = fm + ((wgid % nig) % gsz); u.pn = (wgid % nig) / gsz; u.kb = 0; u.br = 0; return true;
    }
    __device__ __forceinline__ void a_ready(const Unit&) const {}
    __device__ __forceinline__ void done(const Unit&) const {}
};

template <class Epi, class Sched, bool ALIGN_EPI = false, bool SP2 = false, bool HOOK = false>
__device__ __forceinline__ void gemm_phase(PG8_LAS unsigned char* lds, const Gemm g, const Sched& S, const Epi& E) {
    int tid_ = threadIdx.x; asm volatile("" : "+v"(tid_));
    const int tid = tid_, wid = __builtin_amdgcn_readfirstlane(tid >> 6), lane = tid & 63, wr = wid >> 2, wc = wid & 3, fr = lane & 15, fq = lane >> 4;
    const int K = g.K, nt = g.nt;
    unsigned voffA[2], voffB[2];
#pragma unroll
    for (int i = 0; i < 2; ++i) { int R, C; stage_rc(tid * 16 + i * 8192, R, C); const int Rb = Epi::PERM ? ((R & ~31) + perm32(R & 31)) : R;
        voffA[i] = (unsigned)(R * K + C) * 2u; voffB[i] = (unsigned)(Rb * K + C) * 2u; }
    const size_t kstep = (size_t)(BK * 2);
    const size_t hstep = (size_t)HALF * K * 2;
    const size_t tstep = 2 * hstep;
    const unsigned ldsw = (unsigned)wid * 1024u;
    const int aoff = lds_byte(wr * 64 + fr, fq * 8), boff = lds_byte(wc * 32 + fr, fq * 8);
#define PG8_SA(b, h) (((b) * 2 + (h)) * HTB)
#define PG8_SB(b, h) ((4 + (b) * 2 + (h)) * HTB)
#define PG8_STAGE(bufoff, gbase, voff) do { _Pragma("unroll") for (int _i = 0; _i < 2; ++_i) \
        __builtin_amdgcn_global_load_lds((const unsigned*)((const char*)(gbase) + (voff)[_i]), (PG8_LAS unsigned*)(lds + (bufoff) + ldsw + _i * 8192), 16, 0, 0); } while (0)
#define PG8_LDA(dst, b, h) do { _Pragma("unroll") for (int m = 0; m < 4; ++m) _Pragma("unroll") for (int k = 0; k < 2; ++k) dst[m][k] = *(const PG8_LAS bf16x8*)(lds + PG8_SA(b, h) + aoff + m * 2048 + k * 1024); } while (0)
#define PG8_LDB(dst, b, h) do { _Pragma("unroll") for (int n = 0; n < 2; ++n) _Pragma("unroll") for (int k = 0; k < 2; ++k) dst[n][k] = *(const PG8_LAS bf16x8*)(lds + PG8_SB(b, h) + boff + n * 2048 + k * 1024); } while (0)
#define PG8_MMA(ai, bj, At, Bt) do { __builtin_amdgcn_s_setprio(1); _Pragma("unroll") for (int m = 0; m < 4; ++m) _Pragma("unroll") for (int n = 0; n < 2; ++n) _Pragma("unroll") for (int k = 0; k < 2; ++k) \
        acc[ai][bj][m][n] = __builtin_amdgcn_mfma_f32_16x16x32_bf16(Bt[n][k], At[m][k], acc[ai][bj][m][n], 0, 0, 0); __builtin_amdgcn_s_setprio(0); } while (0)
#define PG8_WAIT_V(n) asm volatile("s_waitcnt vmcnt(" #n ")" ::: "memory")
#define PG8_WAIT_L(n) asm volatile("s_waitcnt lgkmcnt(" #n ")" ::: "memory")
#define PG8_BAR __builtin_amdgcn_s_barrier()
#define PG8_SCHED __builtin_amdgcn_sched_barrier(0)
    Unit cur, nxt; int ui = 0;
    if (!S.next(0, cur)) return;
    f32x4 acc[2][2][4][2];
#pragma unroll
    for (int a = 0; a < 2; ++a)
#pragma unroll
        for (int b = 0; b < 2; ++b)
#pragma unroll
            for (int m = 0; m < 4; ++m)
#pragma unroll
                for (int n = 0; n < 2; ++n) acc[a][b][m][n] = (f32x4){0.f, 0.f, 0.f, 0.f};
    bf16x8 At[4][2], B0[2][2], B1[2][2];
    const char* cA = (const char*)g.A + (size_t)cur.pm * tstep + cur.kb; const char* cB = (const char*)g.Bt + (size_t)cur.pn * tstep + cur.kb;
    S.a_ready(cur);
    if constexpr (SP2) {
        PG8_STAGE(PG8_SB(0, 0), cB, voffB); PG8_STAGE(PG8_SB(0, 1), cB + hstep, voffB); PG8_STAGE(PG8_SA(0, 0), cA, voffA); PG8_STAGE(PG8_SA(0, 1), cA + hstep, voffA);
        if (wr == 1) PG8_BAR;
        PG8_WAIT_V(2); PG8_BAR;
        PG8_STAGE(PG8_SB(1, 0), cB + kstep, voffB); PG8_STAGE(PG8_SA(1, 0), cA + kstep, voffA); PG8_STAGE(PG8_SB(1, 1), cB + hstep + kstep, voffB);
        PG8_WAIT_V(6); PG8_BAR;
    } else {
        PG8_STAGE(PG8_SB(0, 0), cB, voffB); PG8_STAGE(PG8_SA(0, 0), cA, voffA); PG8_STAGE(PG8_SB(0, 1), cB + hstep, voffB); PG8_STAGE(PG8_SA(0, 1), cA + hstep, voffA);
        if (wr == 1) PG8_BAR;
        PG8_WAIT_V(4); PG8_BAR;
        PG8_STAGE(PG8_SB(1, 0), cB + kstep, voffB); PG8_STAGE(PG8_SA(1, 0), cA + kstep, voffA); PG8_STAGE(PG8_SB(1, 1), cB + hstep + kstep, voffB);
        PG8_WAIT_V(6); PG8_BAR;
    }
    for (;;) {
        const bool has_next = S.next(ui + 1, nxt);
        const char* nA = has_next ? (const char*)g.A + (size_t)nxt.pm * tstep + nxt.kb : cA; const char* nB = has_next ? (const char*)g.Bt + (size_t)nxt.pn * tstep + nxt.kb : cB;
        for (int t = 0; t < nt; t += 2) {
            const bool last = (t == nt - 2);
            const char* a1 = cA + (size_t)(t + 1) * kstep;
            const char* a2 = last ? nA : cA + (size_t)(t + 2) * kstep; const char* b2 = last ? nB : cB + (size_t)(t + 2) * kstep;
            const char* a3 = a2 + kstep; const char* b3 = b2 + kstep;
            if (last && has_next) S.a_ready(nxt);
            if constexpr (SP2) {
            PG8_LDB(B0, 0, 0); PG8_LDB(B1, 0, 1); PG8_SCHED; PG8_LDA(At, 0, 0); PG8_STAGE(PG8_SA(1, 1), a1 + hstep, voffA);
            PG8_WAIT_V(8); PG8_WAIT_L(0); PG8_BAR; PG8_MMA(0, 0, At, B0); PG8_MMA(0, 1, At, B1); PG8_BAR; PG8_SCHED;
            PG8_LDA(At, 0, 1); PG8_STAGE(PG8_SB(0, 0), b2, voffB); PG8_STAGE(PG8_SB(0, 1), b2 + hstep, voffB); PG8_STAGE(PG8_SA(0, 0), a2, voffA);
            PG8_WAIT_V(8); PG8_WAIT_L(0); PG8_BAR; PG8_MMA(1, 0, At, B0); PG8_MMA(1, 1, At, B1); PG8_BAR; PG8_SCHED;
            PG8_LDB(B0, 1, 0); PG8_LDB(B1, 1, 1); PG8_SCHED; PG8_LDA(At, 1, 0); PG8_STAGE(PG8_SA(0, 1), a2 + hstep, voffA);
            PG8_WAIT_V(8); PG8_WAIT_L(0); PG8_BAR; PG8_MMA(0, 0, At, B0); PG8_MMA(0, 1, At, B1); PG8_BAR; PG8_SCHED;
            PG8_LDA(At, 1, 1); PG8_STAGE(PG8_SB(1, 0), b3, voffB); PG8_STAGE(PG8_SB(1, 1), b3 + hstep, voffB); PG8_STAGE(PG8_SA(1, 0), a3, voffA);
            PG8_WAIT_V(8); PG8_WAIT_L(0); PG8_BAR; PG8_MMA(1, 0, At, B0); PG8_MMA(1, 1, At, B1); PG8_BAR; PG8_SCHED;
            } else {
            PG8_LDB(B0, 0, 0); PG8_SCHED; PG8_LDA(At, 0, 0); PG8_STAGE(PG8_SA(1, 1), a1 + hstep, voffA);
            PG8_WAIT_L(8); PG8_BAR; PG8_WAIT_L(0); PG8_MMA(0, 0, At, B0); PG8_BAR; PG8_SCHED;
            PG8_LDB(B1, 0, 1); PG8_STAGE(PG8_SB(0, 0), b2, voffB);
            PG8_BAR; PG8_WAIT_L(0); PG8_MMA(0, 1, At, B1); PG8_BAR;
            PG8_LDA(At, 0, 1); PG8_STAGE(PG8_SA(0, 0), a2, voffA);
            PG8_BAR; PG8_WAIT_L(0); PG8_MMA(1, 0, At, B0); PG8_BAR; PG8_SCHED;
            PG8_STAGE(PG8_SB(0, 1), b2 + hstep, voffB);
            PG8_WAIT_V(6); PG8_BAR; PG8_MMA(1, 1, At, B1); PG8_BAR;
            PG8_LDB(B0, 1, 0); PG8_SCHED; PG8_LDA(At, 1, 0); PG8_STAGE(PG8_SA(0, 1), a2 + hstep, voffA);
            PG8_WAIT_L(8); PG8_BAR; PG8_WAIT_L(0); PG8_MMA(0, 0, At, B0); PG8_BAR; PG8_SCHED;
            PG8_LDB(B1, 1, 1); PG8_STAGE(PG8_SB(1, 0), b3, voffB);
            PG8_BAR; PG8_WAIT_L(0); PG8_MMA(0, 1, At, B1); PG8_BAR;
            PG8_LDA(At, 1, 1); PG8_STAGE(PG8_SA(1, 0), a3, voffA);
            PG8_BAR; PG8_WAIT_L(0); PG8_MMA(1, 0, At, B0); PG8_BAR; PG8_SCHED;
            PG8_STAGE(PG8_SB(1, 1), b3 + hstep, voffB);
            PG8_WAIT_V(6); PG8_BAR; PG8_MMA(1, 1, At, B1); PG8_BAR;
            }
        }
        if constexpr (ALIGN_EPI) { if (wr == 0) PG8_BAR; }
        if constexpr (HOOK) { E.sub(acc, cur, wr, wc, fr, fq); S.done(cur); }
        else if constexpr (!Epi::AFTER_DRAIN) { E(acc, cur, wr, wc, fr, fq); S.done(cur); }
        if (!has_next) break;
        if constexpr (!HOOK)
#pragma unroll
        for (int a = 0; a < 2; ++a)
#pragma unroll
            for (int b = 0; b < 2; ++b)
#pragma unroll
                for (int m = 0; m < 4; ++m)
#pragma unroll
                    for (int n = 0; n < 2; ++n) acc[a][b][m][n] = (f32x4){0.f, 0.f, 0.f, 0.f};
        cur = nxt; cA = nA; cB = nB; ++ui;
        if constexpr (ALIGN_EPI) { if (wr == 1) PG8_BAR; }
    }
    PG8_WAIT_V(0);
    if constexpr (!ALIGN_EPI) { if (wr == 0) PG8_BAR; }
    PG8_BAR;
    if constexpr (Epi::AFTER_DRAIN) { E.fused(acc, cur, wr, wc, fr, fq, lds, wid, lane); S.done(cur); }
#undef PG8_SA
#undef PG8_SB
#undef PG8_STAGE
#undef PG8_LDA
#undef PG8_LDB
#undef PG8_MMA
#undef PG8_WAIT_V
#undef PG8_WAIT_L
#undef PG8_BAR
#undef PG8_SCHED
}
}
#define LAS __attribute__((address_space(3)))
#define XB_TMO      128
#define XB_XCNT(j)  (256  + 64 * (j))
#define XB_XSUB(j)  (1280 + 64 * (j))
#define XB_XGEN(j)  (2304 + 64 * (j))
#define XB_TOP      3328
#define XB_TOPGEN   3392
#define XCD_BAR_WORDS 3456
#define XB_SPIN_CAP (1u << 18)

__device__ __forceinline__ unsigned xb_ld(unsigned* p)              { return __hip_atomic_load(p, __ATOMIC_RELAXED, __HIP_MEMORY_SCOPE_AGENT); }
__device__ __forceinline__ unsigned xb_add(unsigned* p, unsigned v) { return __hip_atomic_fetch_add(p, v, __ATOMIC_RELAXED, __HIP_MEMORY_SCOPE_AGENT); }
__device__ __forceinline__ unsigned xb_xcc_id() { return (unsigned)__builtin_amdgcn_s_getreg((3 << 11) | 20) & 0xFu; }
#define XB_SPIN(cond, bar) do { unsigned _sp = 0; while (cond) { __builtin_amdgcn_s_sleep(1); \
    if ((++_sp & 255u) == 0u) { if (xb_ld(&(bar)[XB_TMO])) break; if (_sp > XB_SPIN_CAP) { atomicAdd(&(bar)[XB_TMO], 1u); break; } } } } while (0)

struct XcdBarrier {
    unsigned* bar; unsigned x;
    volatile LAS unsigned* st;
};

__device__ __forceinline__ XcdBarrier xcd_barrier_post(unsigned* bar, volatile LAS unsigned* st) {
    XcdBarrier b; b.bar = bar; b.x = xb_xcc_id(); b.st = st;
    if (threadIdx.x == 0) (void)xb_add(&bar[XB_XCNT(b.x)], 1u);
    return b;
}
__device__ __forceinline__ void xcd_barrier_complete(unsigned* bar, unsigned x, unsigned& nloc, unsigned& nx) {
    const unsigned G = gridDim.x * gridDim.y * gridDim.z;
    unsigned sum, cnt, mine, sp = 0u;
    for (;;) {
        sum = 0u; cnt = 0u; mine = 0u;
#pragma unroll
        for (unsigned j = 0; j < 16; ++j) { const unsigned c = xb_ld(&bar[XB_XCNT(j)]); sum += c; cnt += (c > 0u) ? 1u : 0u; mine = (j == x) ? c : mine; }
        if (sum == G) break;
        __builtin_amdgcn_s_sleep(1);
        if ((++sp & 255u) == 0u) { if (xb_ld(&bar[XB_TMO])) break; if (sp > XB_SPIN_CAP) { atomicAdd(&bar[XB_TMO], 1u); break; } }
    }
    nloc = mine > 0u ? mine : 1u; nx = cnt > 0u ? cnt : 1u;
}

__device__ __forceinline__ void xcd_barrier(const XcdBarrier& b) {
    asm volatile("s_waitcnt vmcnt(0)" ::: "memory");
    __syncthreads();
    if (threadIdx.x == 0) {
        unsigned* bar = b.bar; asm volatile("" : "+s"(bar));
        __builtin_amdgcn_s_waitcnt(0);
        unsigned nloc = b.st[0], nx = b.st[1];
        if (nloc == 0u) { xcd_barrier_complete(bar, b.x, nloc, nx); b.st[0] = nloc; b.st[1] = nx; }
        const unsigned old = xb_add(&bar[XB_XSUB(b.x)], 1u);
        const unsigned gen = old / nloc;
        if (old + 1u == (gen + 1u) * nloc) {
            __builtin_amdgcn_fence(__ATOMIC_RELEASE, "agent");
            asm volatile("s_waitcnt vmcnt(0)" ::: "memory");
            const unsigned og = xb_add(&bar[XB_TOP], 1u);
            const unsigned tg = og / nx;
            if (og + 1u == (tg + 1u) * nx) xb_add(&bar[XB_TOPGEN], 1u);
            else XB_SPIN(xb_ld(&bar[XB_TOPGEN]) == tg, bar);
            __builtin_amdgcn_fence(__ATOMIC_ACQUIRE, "agent");
            xb_add(&bar[XB_XGEN(b.x)], 1u);
            asm volatile("s_waitcnt vmcnt(0)" ::: "memory");
        } else {
            XB_SPIN(xb_ld(&bar[XB_XGEN(b.x)]) == gen, bar);
            __builtin_amdgcn_fence(__ATOMIC_ACQUIRE, "agent");
            asm volatile("s_waitcnt vmcnt(0)" ::: "memory");
        }
    }
    __syncthreads();
}

#define DI __device__ __forceinline__
#define LAS __attribute__((address_space(3)))
typedef unsigned short bf16_t;
typedef short bf16x8 __attribute__((ext_vector_type(8)));
typedef short s16x4 __attribute__((ext_vector_type(4)));
typedef float f32x4 __attribute__((ext_vector_type(4)));
typedef float f32x16 __attribute__((ext_vector_type(16)));
typedef unsigned u32x4 __attribute__((ext_vector_type(4)));
typedef unsigned u32x2 __attribute__((ext_vector_type(2)));
typedef float f32x2_t __attribute__((ext_vector_type(2)));
typedef __bf16 bf16x2_t __attribute__((ext_vector_type(2)));

constexpr int DM = 1024, NBATCH = 16, SEQ = 2048, CTXL = 256, DEPTH = 4;
constexpr int MLAT = NBATCH * SEQ, MCTX = NBATCH * CTXL, MTOT = MLAT + MCTX;
constexpr int PROJ = 8448;
constexpr int GI1_TILES = 21, GI2_TILES = 12;
constexpr float EPS = 1e-6f;
constexpr float QSCALE = 0.125f * 1.4426950408889634f;
constexpr int NTHREADS = 512;
constexpr int LDS_BYTES = 147456;

constexpr size_t MiB = 1u << 20;
constexpr size_t WS_MOD = 0;
constexpr size_t WS_ROPE = 896 * 1024;
constexpr size_t WS_LAM = 960 * 1024;
constexpr size_t WS_BAR = 976 * 1024;
constexpr size_t WS_WIN = 1 * MiB;
constexpr size_t WS_WM = 67 * MiB;
constexpr size_t WS_WO = 79 * MiB;
constexpr size_t WS_XC = 87 * MiB;
constexpr size_t WS_H = 103 * MiB;
constexpr size_t WS_SGP = 175 * MiB;
constexpr size_t WS_R = 283 * MiB;
constexpr size_t WS_G = WS_R;
constexpr size_t WS_QA = WS_R, WS_QC = WS_R + 36 * MiB, WS_KC = WS_R + 72 * MiB, WS_VC = WS_R + 108 * MiB, WS_U = WS_R + 144 * MiB,
                 WS_KA = WS_R + 180 * MiB, WS_VA = WS_R + 189 * MiB;
constexpr size_t WS_END = WS_R + 216 * MiB;

struct Params {
  const float *x, *c, *ctx, *c_ctx, *w_mod, *b_mod, *w_in, *qn, *kn, *convw, *lq1, *lk1, *lq2, *lk2, *subln, *wa, *wb, *wc, *wo, *fnorm;
  float* out; unsigned char* ws; float lam_init[4];
};

DI unsigned pk2(float lo, float hi) { f32x2_t v = {lo, hi}; bf16x2_t b = __builtin_convertvector(v, bf16x2_t); return __builtin_bit_cast(unsigned, b); }
DI u32x2 pack4(f32x4 v) { return (u32x2){pk2(v[0], v[1]), pk2(v[2], v[3])}; }
DI f32x4 unpack4(u32x2 w) { return (f32x4){__uint_as_float(w.x << 16), __uint_as_float(w.x & 0xffff0000u), __uint_as_float(w.y << 16), __uint_as_float(w.y & 0xffff0000u)}; }
DI float fexp2(float x) { return __builtin_amdgcn_exp2f(x); }
DI float frcp(float x) { return __builtin_amdgcn_rcpf(x); }
DI float sigmoidf_(float x) { return frcp(1.0f + fexp2(-1.4426950408889634f * x)); }
DI float siluf_(float x) { return x * sigmoidf_(x); }
DI int opaque_tid() { int t = threadIdx.x; asm volatile("" : "+v"(t)); return t; }
DI float wave_sum(float v) {
#pragma unroll
  for (int o = 1; o < 64; o <<= 1) v += __shfl_xor(v, o);
  return v;
}

DI int logical_col(int p) {
  const int pn = p >> 8, pc = p & 255;
  const int bj = pc >> 7, wc = (pc >> 5) & 3, e32 = pc & 31, n = (pc >> 4) & 1, e16 = pc & 15;
  if (pn <= 2) return 256 * pn + 64 * wc + 32 * bj + e32;
  if (pn <= 10) return 1280 + 512 * (2 * bj + n) + 64 * (pn - 3) + 16 * wc + e16;
  if (pn <= 14) return 3328 + 256 * (pn - 11) + 64 * wc + 32 * bj + e32;
  if (pn <= 16) return 4352 + 256 * (pn - 15) + pc;
  if (pn <= 18) return 768 + 256 * (pn - 17) + pc;
  if (pn <= 20) return 4864 + 256 * (pn - 19) + pc;
  return 5376 + 256 * (pn - 21) + 128 * bj + 32 * wc + 8 * ((pc >> 2) & 3) + 4 * n + (pc & 3);
}

struct EpiGI {
  static constexpr bool PERM = false, AFTER_DRAIN = false;
  bf16_t *Qa, *Ka, *Va, *Qc, *Kc, *Vc, *U, *SGP, *G; const float *qn, *kn, *rope; int pn_off;

  DI void head_tile(const pg8::f32x4 (&acc)[2][2][4][2], int row0, int fq, bool donorm, const float* gw, bf16_t* dst, int pitch, int dcol, float scale, bool rope_on) const {
#pragma unroll
    for (int ai = 0; ai < 2; ++ai)
#pragma unroll
      for (int m = 0; m < 4; ++m) {
        const int row = row0 + 128 * ai + 16 * m;
        f32x4 v[2][2];
#pragma unroll
        for (int bj = 0; bj < 2; ++bj)
#pragma unroll
          for (int n = 0; n < 2; ++n) v[bj][n] = acc[ai][bj][m][n];
        if (donorm) {
          float ss = 0.f;
#pragma unroll
          for (int bj = 0; bj < 2; ++bj)
#pragma unroll
            for (int n = 0; n < 2; ++n) ss += (v[bj][n][0] * v[bj][n][0] + v[bj][n][1] * v[bj][n][1]) + (v[bj][n][2] * v[bj][n][2] + v[bj][n][3] * v[bj][n][3]);
          ss += __shfl_xor(ss, 16); ss += __shfl_xor(ss, 32);
          const float rs = 1.0f / sqrtf(ss * (1.0f / 64.0f) + EPS);
#pragma unroll
          for (int bj = 0; bj < 2; ++bj)
#pragma unroll
            for (int n = 0; n < 2; ++n) v[bj][n] = v[bj][n] * rs * *(const f32x4*)(gw + 32 * bj + 16 * n + 4 * fq);
        }
        if (rope_on) {
          const int s = row & (SEQ - 1);
#pragma unroll
          for (int bj = 0; bj < 2; ++bj) {
            const int pos = bj == 0 ? (s >> 6) : (s & 63);
            const f32x4 t0 = *(const f32x4*)(rope + (pos * 16 + 4 * fq) * 2), t1 = *(const f32x4*)(rope + (pos * 16 + 4 * fq) * 2 + 4);
            const f32x4 cs = {t0[0], t0[2], t1[0], t1[2]}, sn = {t0[1], t0[3], t1[1], t1[3]};
            const f32x4 x1 = v[bj][0], x2 = v[bj][1];
            v[bj][0] = x1 * cs - x2 * sn; v[bj][1] = x2 * cs + x1 * sn;
          }
        }
#pragma unroll
        for (int bj = 0; bj < 2; ++bj)
#pragma unroll
          for (int n = 0; n < 2; ++n) *(u32x2*)(dst + (size_t)row * pitch + dcol + 32 * bj + 16 * n + 4 * fq) = pack4(v[bj][n] * scale);
        asm volatile("" ::: "memory");
      }
  }

  DI void operator()(const pg8::f32x4 (&acc)[2][2][4][2], const pg8::Unit& u, int wr, int wc, int fr, int fq) const {
    asm volatile("" : "+v"(fr), "+v"(fq));
    const int pn = u.pn + pn_off;
    const int row0 = u.pm * 256 + wr * 64 + fr;
    const bool lat = u.pm < (MLAT / 256);
    if (pn <= 1) head_tile(acc, row0, fq, true, qn, Qa, 512, 64 * (4 * pn + wc), QSCALE, lat);
    else if (pn == 2) { if (wc < 2) head_tile(acc, row0, fq, true, kn, Ka, 128, 64 * wc, 1.0f, lat); else head_tile(acc, row0, fq, false, kn, Va, 128, 64 * (wc - 2), 1.0f, false); }
    else if (pn <= 10) {
      const int ch = 64 * (pn - 3) + 16 * wc + 4 * fq;
#pragma unroll
      for (int ai = 0; ai < 2; ++ai)
#pragma unroll
        for (int m = 0; m < 4; ++m) {
          const int row = row0 + 128 * ai + 16 * m;
          const f32x4 bh = acc[ai][0][m][0], bb = acc[ai][0][m][1], bc = acc[ai][1][m][0], bg = acc[ai][1][m][1];
          f32x4 pre;
#pragma unroll
          for (int e = 0; e < 4; ++e) pre[e] = siluf_(bg[e]) * bb[e];
          *(u32x2*)(U + (size_t)row * 512 + ch) = pack4(bc * bh);
          *(u32x2*)(SGP + (size_t)row * 1536 + 512 + ch) = pack4(pre);
        }
    }
    else if (pn <= 12) head_tile(acc, row0, fq, false, qn, Qc, 512, 256 * (pn - 11) + 64 * wc, QSCALE, lat);
    else if (pn <= 14) head_tile(acc, row0, fq, false, qn, Kc, 512, 256 * (pn - 13) + 64 * wc, 1.0f, lat);
    else if (pn >= 21) {
      unsigned char* dst = (unsigned char*)G + (size_t)((pn - 21) >> 2) * ((size_t)MTOT * 1024) + 256 * ((pn - 21) & 3) + 32 * wc + 8 * fq;
#pragma unroll
      for (int ai = 0; ai < 2; ++ai)
#pragma unroll
        for (int m = 0; m < 4; ++m) {
          const int row = row0 + 128 * ai + 16 * m;
#pragma unroll
          for (int bj = 0; bj < 2; ++bj) {
            u32x2 wv;
#pragma unroll
            for (int n = 0; n < 2; ++n) {
              const f32x4 v = acc[ai][bj][m][n]; unsigned wq = 0u;
#pragma unroll
              for (int e = 0; e < 4; ++e) { const float q = fmaxf(__builtin_fmaf(255.0f, frcp(1.0f + fexp2(-1.4426950408889634f * v[e])), 0.5f), 1.0f); wq |= ((unsigned)q) << (8 * e); }
              wv[n] = wq;
            }
            *(u32x2*)(dst + (size_t)row * 1024 + 128 * bj) = wv;
          }
        }
    }
    else {
      bf16_t* dst; int pitch, dcol, act;
      if (pn <= 16) { dst = Vc; pitch = 512; dcol = 256 * (pn - 15); act = 0; }
      else if (pn <= 20) { dst = SGP; pitch = 1536; dcol = (pn < 19 ? 0 : 1024) + 256 * ((pn - 17) & 1); act = 1; }
      else { dst = G + (size_t)((pn - 21) >> 2) * ((size_t)MTOT * 1024); pitch = 1024; dcol = 256 * ((pn - 21) & 3); act = 2; }
#pragma unroll
      for (int ai = 0; ai < 2; ++ai)
#pragma unroll
        for (int m = 0; m < 4; ++m) {
          const int row = row0 + 128 * ai + 16 * m;
#pragma unroll
          for (int bj = 0; bj < 2; ++bj)
#pragma unroll
            for (int n = 0; n < 2; ++n) {
              f32x4 v = acc[ai][bj][m][n];
              if (act == 1) {
#pragma unroll
                for (int e = 0; e < 4; ++e) v[e] = siluf_(v[e]);
              } else if (act == 2) {
#pragma unroll
                for (int e = 0; e < 4; ++e) v[e] = sigmoidf_(v[e]);
              }
              *(u32x2*)(dst + (size_t)row * pitch + dcol + 128 * bj + 32 * wc + 16 * n + 4 * fq) = pack4(v);
            }
        }
    }
  }
};

template <bool SUB3>
struct ListOrder {
  int n; unsigned packed;
  DI void clear() { n = 0; packed = 0u; }
  DI void set0(int pm, int pn) { packed = (unsigned)((pm << 2) | pn); n = 1; }
  DI void set1(int pm, int pn) { packed |= (unsigned)((pm << 2) | pn) << 10; n = 2; }
  DI bool next(int i, pg8::Unit& u) const {
    const int ui = SUB3 ? i / 3 : i; if (ui >= n) return false;
    const int v = (int)((packed >> (10 * ui)) & 1023u);
    u.pm = v >> 2; u.pn = v & 3; u.br = SUB3 ? i % 3 : 0; u.kb = u.br * 1024; return true;
  }
  DI void a_ready(const pg8::Unit&) const {}
  DI void done(const pg8::Unit&) const {}
};
struct EpiGM {
  static constexpr bool PERM = true, AFTER_DRAIN = false;
  const unsigned char* G; bf16_t* MG;
  DI void operator()(const pg8::f32x4 (&acc)[2][2][4][2], const pg8::Unit& u, int wr, int wc, int fr, int fq) const {}
  DI void sub(pg8::f32x4 (&acc)[2][2][4][2], const pg8::Unit& u, int wr, int wc, int fr, int fq) const {
    asm volatile("" : "+v"(fr), "+v"(fq));
    const int br = u.br;
    const unsigned char* gn = G + (size_t)br * ((size_t)MTOT * 1024);
    const unsigned char* gd = G + (size_t)(br < 2 ? br + 1 : 2) * ((size_t)MTOT * 1024);
    const int row0 = u.pm * 256 + wr * 64 + fr, col0 = u.pn * 256 + 32 * wc + 8 * fq;
#pragma unroll
    for (int ai = 0; ai < 2; ++ai) {
      u32x2 ga[4][2], gb[4][2];
#pragma unroll
      for (int m = 0; m < 4; ++m)
#pragma unroll
        for (int bj = 0; bj < 2; ++bj) {
          const size_t ro = (size_t)(row0 + 128 * ai + 16 * m) * 1024 + col0 + 128 * bj;
          ga[m][bj] = *(const u32x2*)(gn + ro); gb[m][bj] = (br < 2) ? *(const u32x2*)(gd + ro) : ga[m][bj];
        }
#pragma unroll
      for (int m = 0; m < 4; ++m) {
#pragma unroll
        for (int bj = 0; bj < 2; ++bj) {
          const size_t ro = (size_t)(row0 + 128 * ai + 16 * m) * 1024 + col0 + 128 * bj;
          f32x4 a[2], r[2];
#pragma unroll
          for (int n = 0; n < 2; ++n)
#pragma unroll
            for (int e = 0; e < 4; ++e) {
              a[n][e] = (float)((ga[m][bj][n] >> (8 * e)) & 0xffu);
              const float bq = (float)((gb[m][bj][n] >> (8 * e)) & 0xffu);
              r[n][e] = (br == 2) ? 0.0f : a[n][e] * frcp(bq);
            }
          if (br == 2) { const u32x2 s0 = pack4(acc[ai][bj][m][0] * a[0] * (1.0f / 255.0f)), s1 = pack4(acc[ai][bj][m][1] * a[1] * (1.0f / 255.0f)); *(u32x4*)(MG + ro) = (u32x4){s0[0], s0[1], s1[0], s1[1]}; }
          acc[ai][bj][m][0] = acc[ai][bj][m][0] * r[0]; acc[ai][bj][m][1] = acc[ai][bj][m][1] * r[1];
        }
        asm volatile("" : "+v"(acc[ai][0][m][0]), "+v"(acc[ai][0][m][1]), "+v"(acc[ai][1][m][0]), "+v"(acc[ai][1][m][1]) :: "memory");
      }
    }
  }
};

struct OrderGI {
  pg8::StaticOrder base; int extra;
  DI bool next(int i, pg8::Unit& u) const {
    if (base.next(i, u)) return true;
    const long L = (long)i * base.G + base.c; const int k = (int)(L - base.nwg);
    if (k < 0 || k >= extra) return false;
    const int r = k % 5;
    u.pm = (MLAT / 256) + k / 5; u.pn = r == 0 ? 2 : 12 + r; u.kb = 0; u.br = 0; return true;
  }
  DI void a_ready(const pg8::Unit&) const {}
  DI void done(const pg8::Unit&) const {}
};
DI int late_base(int x) { return 16 * (x + 1) + (x >= 4 ? 8 : 0); }
struct EpiGO {
  static constexpr bool PERM = true, AFTER_DRAIN = false;
  const float *src_lat, *src_ctx; float *dst_lat, *dst_ctx; const float* mod;
  DI void operator()(const pg8::f32x4 (&acc)[2][2][4][2], const pg8::Unit& u, int wr, int wc, int fr, int fq) const {
    asm volatile("" : "+v"(fr), "+v"(fq));
    const int row0 = u.pm * 256 + wr * 64 + fr, col0 = u.pn * 256 + 32 * wc + 8 * fq;
    const bool lat = u.pm < (MLAT / 256);
    const int b = lat ? (u.pm >> 3) : 16;
    const float* gate = mod + b * 3072 + 2048 + col0;
    f32x4 gv[2][2];
#pragma unroll
    for (int bj = 0; bj < 2; ++bj)
#pragma unroll
      for (int n = 0; n < 2; ++n) gv[bj][n] = *(const f32x4*)(gate + 128 * bj + 4 * n);
    const float* src = lat ? src_lat : src_ctx - (size_t)MLAT * 1024;
    float* dst = lat ? dst_lat : dst_ctx - (size_t)MLAT * 1024;
#pragma unroll
    for (int ai = 0; ai < 2; ++ai) {
      f32x4 xo[4][2][2];
#pragma unroll
      for (int m = 0; m < 4; ++m)
#pragma unroll
        for (int bj = 0; bj < 2; ++bj)
#pragma unroll
          for (int n = 0; n < 2; ++n) xo[m][bj][n] = *(const f32x4*)(src + (size_t)(row0 + 128 * ai + 16 * m) * 1024 + col0 + 128 * bj + 4 * n);
#pragma unroll
      for (int m = 0; m < 4; ++m)
#pragma unroll
        for (int bj = 0; bj < 2; ++bj)
#pragma unroll
          for (int n = 0; n < 2; ++n) *(f32x4*)(dst + (size_t)(row0 + 128 * ai + 16 * m) * 1024 + col0 + 128 * bj + 4 * n) = xo[m][bj][n] + gv[bj][n] * acc[ai][bj][m][n];
      asm volatile("" ::: "memory");
    }
  }
};

template <bool PERMUTE>
DI void p0_item(const float* W, int N, bf16_t* WT, int ldo, int ocol, int k0, int p0, LAS float* scr, int lane) {
  const int src = PERMUTE ? logical_col(p0 + (lane & 31)) : p0 + (lane & 31);
#pragma unroll 16
  for (int i = 0; i < 32; ++i) { const int kk = 2 * i + (lane >> 5); scr[kk * 33 + (lane & 31)] = W[(size_t)(k0 + kk) * N + src]; }
  asm volatile("s_waitcnt lgkmcnt(0)" ::: "memory");
  const int c = lane & 7;
#pragma unroll
  for (int j = 0; j < 4; ++j) {
    const int n = (lane >> 3) + 8 * j; const LAS float* s = scr + (8 * c) * 33 + n;
    u32x4 o; o.x = pk2(s[0 * 33], s[1 * 33]); o.y = pk2(s[2 * 33], s[3 * 33]); o.z = pk2(s[4 * 33], s[5 * 33]); o.w = pk2(s[6 * 33], s[7 * 33]);
    *(u32x4*)(WT + (size_t)(p0 + n) * ldo + ocol + k0 + 8 * c) = o;
  }
  asm volatile("s_waitcnt lgkmcnt(0)" ::: "memory");
}

DI void sincos_red(float ang, float& s, float& c) {
  const double a = (double)ang;
  const double q = __builtin_rint(a * 0.63661977236758134308);
  const float r = (float)(a - q * 1.57079632679489661923);
  const float r2 = r * r;
  const float sp = r + r * r2 * (-1.6666654611e-1f + r2 * (8.3321608736e-3f + r2 * (-1.9515295891e-4f)));
  const float cp = 1.0f + r2 * (-0.5f + r2 * (4.166664568298827e-2f + r2 * (-1.388731625493765e-3f + r2 * 2.443315711809948e-5f)));
  const int qi = ((int)q) & 3;
  s = (qi == 0) ? sp : (qi == 1) ? cp : (qi == 2) ? -sp : -cp;
  c = (qi == 0) ? cp : (qi == 1) ? -sp : (qi == 2) ? -cp : sp;
}

DI void phase0(const Params& P, LAS unsigned char* lds) {
  const int tid = opaque_tid(), lane = tid & 63, w = tid >> 6, G = gridDim.x, bid = blockIdx.x;
  float* MOD = (float*)(P.ws + WS_MOD);
  for (int item = bid; item < 192; item += G) {
    LAS float* sc = (LAS float*)(lds + 67584);
    for (int i = tid; i < 17 * 1024; i += NTHREADS) { const float v = i < 16384 ? P.c[i] : P.c_ctx[i - 16384]; sc[i] = v / (1.0f + __expf(-v)); }
    __syncthreads();
    const int l = item / 48, n0 = (item % 48) * 64;
    const float* W = P.w_mod + (size_t)l * 1024 * 3072 + n0 + lane;
    float acc[17];
#pragma unroll
    for (int b = 0; b < 17; ++b) acc[b] = 0.f;
    const int kb = w * 128;
#pragma unroll 4
    for (int k = kb; k < kb + 128; k += 4) {
      const float w0 = W[(size_t)k * 3072], w1 = W[(size_t)(k + 1) * 3072], w2 = W[(size_t)(k + 2) * 3072], w3 = W[(size_t)(k + 3) * 3072];
#pragma unroll
      for (int b = 0; b < 17; ++b) { const f32x4 s = *(const LAS f32x4*)(sc + b * 1024 + k); acc[b] += (s[0] * w0 + s[1] * w1) + (s[2] * w2 + s[3] * w3); }
    }
    LAS float* red = (LAS float*)lds;
#pragma unroll
    for (int b = 0; b < 17; ++b) red[(w * 17 + b) * 64 + lane] = acc[b];
    __syncthreads();
    for (int i = tid; i < 17 * 64; i += NTHREADS) {
      const int b = i >> 6, ln = i & 63; float s = 0.f;
#pragma unroll
      for (int ww = 0; ww < 8; ++ww) s += red[(ww * 17 + b) * 64 + ln];
      MOD[(size_t)(l * 17 + b) * 3072 + n0 + ln] = s + P.b_mod[l * 3072 + n0 + ln];
    }
    __syncthreads();
  }
  if (bid == G - 1) {
    float* rope = (float*)(P.ws + WS_ROPE);
    for (int i = tid; i < 1024; i += NTHREADS) {
      const int pos = i >> 4, f = i & 15;
      const float inv = exp2f(-(float)f * (13.287712379549449f / 16.0f));
      float s, c; sincos_red((float)pos * inv, s, c);
      rope[2 * i] = c; rope[2 * i + 1] = s;
    }
    if (w < DEPTH) {
      float a = P.lq1[w * 64 + lane] * P.lk1[w * 64 + lane], b = P.lq2[w * 64 + lane] * P.lk2[w * 64 + lane];
      a = wave_sum(a); b = wave_sum(b);
      if (lane == 0) ((float*)(P.ws + WS_LAM))[w] = expf(a) - expf(b) + P.lam_init[w];
    }
  }
  LAS float* scr = (LAS float*)(lds + w * 8448);
  const int gw = bid * 8 + w, NGW = G * 8;
  constexpr int PER_L = 4224 + 768 + 512;
  for (int it = gw; it < DEPTH * PER_L; it += NGW) {
    const int l = it / PER_L; int r = it % PER_L;
    if (r < 4224) { p0_item<true>(P.w_in + (size_t)l * 1024 * PROJ, PROJ, (bf16_t*)(P.ws + WS_WIN) + (size_t)l * PROJ * 1024, 1024, 0, 64 * (r / 264), 32 * (r % 264), scr, lane); continue; }
    r -= 4224;
    if (r < 768) { const int br = r >> 8, rr = r & 255; const float* W = (br == 0 ? P.wa : br == 1 ? P.wb : P.wc) + (size_t)l * 512 * 1024;
      p0_item<false>(W, 1024, (bf16_t*)(P.ws + WS_WM) + (size_t)l * 1024 * 1536, 1536, 512 * br, 64 * (rr >> 5), 32 * (rr & 31), scr, lane); continue; }
    r -= 768;
    p0_item<false>(P.wo + (size_t)l * 1024 * 1024, 1024, (bf16_t*)(P.ws + WS_WO) + (size_t)l * 1024 * 1024, 1024, 0, 64 * (r >> 5), 32 * (r & 31), scr, lane);
  }
}

DI void norm_phase(const Params& P, int l) {
  const int tid = opaque_tid(), lane = tid & 63, w = tid >> 6;
  const int gw = blockIdx.x * 8 + w, NGW = gridDim.x * 8;
  const float* MOD = (const float*)(P.ws + WS_MOD) + (size_t)l * 17 * 3072;
  bf16_t* H = (bf16_t*)(P.ws + WS_H);
  constexpr int NR = 4, QROWS = MTOT / NR;
  for (int rp = gw; rp < QROWS; rp += NGW) {
    f32x4 v[NR][4]; float ss[NR];
#pragma unroll
    for (int q = 0; q < NR; ++q) {
      const int row = rp + q * QROWS;
      const bool lat = row < MLAT;
      const float* src = lat ? ((l == 0 ? P.x : (const float*)P.out) + (size_t)row * 1024) : ((l == 0 ? P.ctx : (const float*)(P.ws + WS_XC)) + (size_t)(row - MLAT) * 1024);
#pragma unroll
      for (int j = 0; j < 4; ++j) v[q][j] = *(const f32x4*)(src + 256 * j + 4 * lane);
    }
#pragma unroll
    for (int q = 0; q < NR; ++q) {
      ss[q] = 0.f;
#pragma unroll
      for (int j = 0; j < 4; ++j) ss[q] += (v[q][j][0] * v[q][j][0] + v[q][j][1] * v[q][j][1]) + (v[q][j][2] * v[q][j][2] + v[q][j][3] * v[q][j][3]);
      ss[q] = wave_sum(ss[q]);
    }
#pragma unroll
    for (int q = 0; q < NR; ++q) {
      const int row = rp + q * QROWS;
      const int b = row < MLAT ? (row >> 11) : 16;
      const float rs = 1.0f / sqrtf(ss[q] * (1.0f / 1024.0f) + EPS);
#pragma unroll
      for (int j = 0; j < 4; ++j) {
        const f32x4 sh = *(const f32x4*)(MOD + b * 3072 + 256 * j + 4 * lane), sc = *(const f32x4*)(MOD + b * 3072 + 1024 + 256 * j + 4 * lane);
        const f32x4 h = v[q][j] * rs * (sc + 1.0f) + sh;
        *(u32x2*)(H + (size_t)row * 1024 + 256 * j + 4 * lane) = pack4(h);
      }
    }
  }
}

DI void final_phase(const Params& P) {
  const int tid = opaque_tid(), lane = tid & 63, w = tid >> 6;
  const int gw = blockIdx.x * 8 + w, NGW = gridDim.x * 8;
  for (int row = gw; row < MLAT; row += NGW) {
    float* src = P.out + (size_t)row * 1024;
    f32x4 v[4]; float ss = 0.f;
#pragma unroll
    for (int j = 0; j < 4; ++j) { v[j] = *(const f32x4*)(src + 256 * j + 4 * lane); ss += (v[j][0] * v[j][0] + v[j][1] * v[j][1]) + (v[j][2] * v[j][2] + v[j][3] * v[j][3]); }
    ss = wave_sum(ss);
    const float rs = 1.0f / sqrtf(ss * (1.0f / 1024.0f) + EPS);
#pragma unroll
    for (int j = 0; j < 4; ++j) { const f32x4 g = *(const f32x4*)(P.fnorm + 256 * j + 4 * lane); f32x4 ov = v[j] * rs * g;
      *(f32x4*)(src + 256 * j + 4 * lane) = ov; }
  }
}

#define MFMA32(a, b, c) __builtin_amdgcn_mfma_f32_32x32x16_bf16((a), (b), (c), 0, 0, 0)
DI int crow(int reg, int h) { return (reg & 3) + 8 * (reg >> 2) + 4 * h; }
DI s16x4 vtr(const LAS unsigned char* p) { return __builtin_bit_cast(s16x4, __builtin_amdgcn_ds_read_tr16_b64_v4i16((LAS s16x4*)p)); }

constexpr int KT_B = 8192;
constexpr int XCH_OFF = 0;
DI void glds16(const void* gsrc, unsigned lds_dst) { unsigned keep;
  asm volatile("s_mov_b32 %0, m0\n\ts_mov_b32 m0, %2\n\ts_nop 0\n\tglobal_load_lds_dwordx4 %1, off\n\ts_mov_b32 m0, %0" : "=&s"(keep) : "v"(gsrc), "s"(lds_dst) : "memory"); }
DI float xhalf_max(float m) { const auto rr = __builtin_amdgcn_permlane32_swap(__float_as_uint(m), __float_as_uint(m), false, false); return fmaxf(__uint_as_float(rr[0]), __uint_as_float(rr[1])); }
DI float xhalf_sum(float m) { const auto rr = __builtin_amdgcn_permlane32_swap(__float_as_uint(m), __float_as_uint(m), false, false); return __uint_as_float(rr[0]) + __uint_as_float(rr[1]); }
#define AT_WAITBAR(N) asm volatile("s_waitcnt vmcnt(" #N ") lgkmcnt(0)\n\ts_barrier" ::: "memory")

template <int MODE>
DI void attn_unit(const Params& P, LAS unsigned char* lds, int l, int b, int hg, int qt, bool ctxunit) {
  constexpr int DV = MODE ? 128 : 64, NK = MODE ? 2 : 1, NVB = MODE ? 2 : 1, VROW = DV * 2, VT_B = 64 * VROW, NDB = DV / 32;
  constexpr int KSLOT = NK * KT_B, VRING = 3 * KSLOT;
  constexpr float THR = 6.0f;
  const int tid = opaque_tid(), lane = tid & 63, r = lane & 31, h = lane >> 5, w = __builtin_amdgcn_readfirstlane(tid >> 6);
  const bf16_t* Kg = (const bf16_t*)(P.ws + (MODE ? WS_KC : WS_KA));
  const bf16_t* Vg = (const bf16_t*)(P.ws + (MODE ? WS_VC : WS_VA));
  const bf16_t* Qg = (const bf16_t*)(P.ws + (MODE ? WS_QC : WS_QA));
  bf16_t* SGP = (bf16_t*)(P.ws + WS_SGP);
  constexpr int KP = MODE ? 512 : 128;
  const int kcol = MODE ? 128 * hg : 64 * hg;
  const int NT = ctxunit ? 4 : 36;
  const int qsub = MODE ? (w & 3) : (w >> 2), kidx = MODE ? (w >> 2) : 0;
  const int qrow = (ctxunit ? MLAT + b * CTXL : b * SEQ) + qt * (MODE ? 128 : 64) + 32 * qsub + r;
  const int qcol = MODE ? 128 * hg + 64 * kidx : 64 * (4 * hg + (w & 3));
  const unsigned lds0 = (unsigned)(uintptr_t)lds;
  const int krow_ = 8 * w + (lane >> 3);
  const int kgo = krow_ * KP + kcol + 8 * ((lane & 7) ^ ((krow_ >> 1) & 7));
  const int vrow_ = MODE ? 4 * w + (lane >> 4) : 8 * w + (lane >> 3);
  const int vgo = MODE ? vrow_ * KP + kcol + 8 * ((lane & 15) ^ ((vrow_ & 3) << 2)) : vrow_ * KP + kcol + 8 * ((lane & 7) ^ (((vrow_ >> 1) & 1) << 2));
#define TILE_ROW(j) (((ctxunit) || (j) < 4) ? MLAT + b * CTXL + 64 * (j) : b * SEQ + 64 * ((j) - 4))
#define DMA_K(t) do { const bf16_t* g_ = Kg + (size_t)TILE_ROW(t) * KP + kgo; const unsigned d_ = lds0 + ((t) % 3) * KSLOT + w * 1024; \
    glds16(g_, (unsigned)__builtin_amdgcn_readfirstlane(d_)); if (MODE) glds16(g_ + 64, (unsigned)__builtin_amdgcn_readfirstlane(d_ + KT_B)); } while (0)
#define DMA_V(t) do { const bf16_t* g_ = Vg + (size_t)TILE_ROW(t) * KP + vgo; const unsigned d_ = lds0 + VRING + ((t) % 3) * VT_B + w * 1024; \
    glds16(g_, (unsigned)__builtin_amdgcn_readfirstlane(d_)); if (MODE) glds16(g_ + 32 * KP, (unsigned)__builtin_amdgcn_readfirstlane(d_ + 8192)); } while (0)
  if (w >= 4) __builtin_amdgcn_s_setprio(1);
  DMA_K(0); DMA_V(0); DMA_K(1); DMA_V(1); if (MODE == 0) DMA_K(2);
  bf16x8 qf[4];
#pragma unroll
  for (int s = 0; s < 4; ++s) qf[s] = *(const bf16x8*)(Qg + (size_t)qrow * 512 + qcol + 16 * s + 8 * h);
  f32x16 o[NDB], negm;
#pragma unroll
  for (int d = 0; d < NDB; ++d)
#pragma unroll
    for (int i = 0; i < 16; ++i) o[d][i] = 0.f;
#pragma unroll
  for (int i = 0; i < 16; ++i) negm[i] = 0.f;
  float mref = 0.f, lrun = 0.f;
  const int i16 = lane & 15, tq = i16 >> 2, tp = i16 & 3;
  int kro[4], vo[NDB];
#pragma unroll
  for (int s = 0; s < 4; ++s) kro[s] = kidx * KT_B + r * 128 + 16 * ((2 * s + h) ^ ((r >> 1) & 7));
  const int vsw = MODE ? tq : ((tq >> 1) & 1);
#pragma unroll
  for (int d = 0; d < NDB; ++d) vo[d] = VRING + (4 * h + tq) * VROW + 64 * (d ^ vsw) + 32 * ((lane >> 4) & 1) + 8 * tp;
  AT_WAITBAR(0);
#define QK(P0, P1, t) do { const LAS unsigned char* Kt_ = lds + ((t) % 3) * KSLOT; \
    _Pragma("unroll") for (int s = 0; s < 4; ++s) { \
      const bf16x8 k0_ = *(const LAS bf16x8*)(Kt_ + kro[s]), k1_ = *(const LAS bf16x8*)(Kt_ + kro[s] + 32 * 128); \
      if (s == 0) { P0 = MFMA32(k0_, qf[0], negm); P1 = MFMA32(k1_, qf[0], negm); } else { P0 = MFMA32(k0_, qf[s], P0); P1 = MFMA32(k1_, qf[s], P1); } } } while (0)
#define VTR(dst, addr, OFF) asm volatile("ds_read_b64_tr_b16 %0, %1 offset:%2" : "=v"(dst) : "v"(addr), "i"(OFF) : "memory")
#define VFRAG(lo_, hi_) __builtin_shufflevector(lo_, hi_, 0, 1, 2, 3, 4, 5, 6, 7)
#define SOFTMAX(C0, C1, N0, N1, j, HASN) \
      \
    float mx_ = 0.f; \
    if (((j) & 3) == 0) { mx_ = fmaxf(C0[0], C1[0]); \
      _Pragma("unroll") for (int i = 1; i < 16; ++i) mx_ = fmaxf(fmaxf(mx_, C0[i]), C1[i]); \
      mx_ = xhalf_max(mx_); } \
    if ((j) == 0 || (((j) & 3) == 0 && __any(mx_ > THR))) { \
      const float dl_ = ((j) == 0) ? mx_ : fmaxf(mx_, 0.f); \
      _Pragma("unroll") for (int i = 0; i < 16; ++i) { C0[i] -= dl_; C1[i] -= dl_; } \
      if (HASN) { if ((j) + 1 < NT) { _Pragma("unroll") for (int i = 0; i < 16; ++i) { N0[i] -= dl_; N1[i] -= dl_; } } } \
      mref += dl_; \
      _Pragma("unroll") for (int i = 0; i < 16; ++i) negm[i] = -mref; \
      const float al_ = fexp2(-dl_); lrun *= al_; \
      _Pragma("unroll") for (int d = 0; d < NDB; ++d) _Pragma("unroll") for (int i = 0; i < 16; ++i) o[d][i] *= al_; \
    } \
    C0[0] = fexp2(C0[0]); C1[0] = fexp2(C1[0]); float sa_ = C0[0], sb_ = C1[0]; \
    _Pragma("unroll") for (int i = 1; i < 16; ++i) { C0[i] = fexp2(C0[i]); C1[i] = fexp2(C1[i]); sa_ += C0[i]; asm("" : "+v"(sa_)); sb_ += C1[i]; } \
    lrun += sa_ + sb_; \
    bf16x8 pb_[4]; \
    { u32x4 t_; \
      t_ = (u32x4){pk2(C0[0], C0[1]), pk2(C0[2], C0[3]), pk2(C0[4], C0[5]), pk2(C0[6], C0[7])}; pb_[0] = __builtin_bit_cast(bf16x8, t_); \
      t_ = (u32x4){pk2(C0[8], C0[9]), pk2(C0[10], C0[11]), pk2(C0[12], C0[13]), pk2(C0[14], C0[15])}; pb_[1] = __builtin_bit_cast(bf16x8, t_); \
      t_ = (u32x4){pk2(C1[0], C1[1]), pk2(C1[2], C1[3]), pk2(C1[4], C1[5]), pk2(C1[6], C1[7])}; pb_[2] = __builtin_bit_cast(bf16x8, t_); \
      t_ = (u32x4){pk2(C1[8], C1[9]), pk2(C1[10], C1[11]), pk2(C1[12], C1[13]), pk2(C1[14], C1[15])}; pb_[3] = __builtin_bit_cast(bf16x8, t_); }
#define STEP_A(C0, C1, N0, N1, j) do { \
    if ((j) + 3 < NT) DMA_K((j) + 3); \
    if ((j) + 2 < NT) DMA_V((j) + 2); \
    if ((j) + 1 < NT) { QK(N0, N1, (j) + 1); } \
    s16x4 vl_[4][2], vh_[4][2]; \
    { const unsigned va0_ = lds0 + ((j) % 3) * VT_B + vo[0], va1_ = lds0 + ((j) % 3) * VT_B + vo[1]; \
      VTR(vl_[0][0], va0_, 0 * VROW); VTR(vh_[0][0], va0_, 8 * VROW); VTR(vl_[0][1], va1_, 0 * VROW); VTR(vh_[0][1], va1_, 8 * VROW); \
      VTR(vl_[1][0], va0_, 16 * VROW); VTR(vh_[1][0], va0_, 24 * VROW); VTR(vl_[1][1], va1_, 16 * VROW); VTR(vh_[1][1], va1_, 24 * VROW); \
      VTR(vl_[2][0], va0_, 32 * VROW); VTR(vh_[2][0], va0_, 40 * VROW); VTR(vl_[2][1], va1_, 32 * VROW); VTR(vh_[2][1], va1_, 40 * VROW); \
      VTR(vl_[3][0], va0_, 48 * VROW); VTR(vh_[3][0], va0_, 56 * VROW); VTR(vl_[3][1], va1_, 48 * VROW); VTR(vh_[3][1], va1_, 56 * VROW); } \
    SOFTMAX(C0, C1, N0, N1, j, true) \
    asm volatile("s_waitcnt lgkmcnt(0)" : "+v"(vl_[0][0]), "+v"(vh_[0][0]), "+v"(vl_[0][1]), "+v"(vh_[0][1]), "+v"(vl_[1][0]), "+v"(vh_[1][0]), "+v"(vl_[1][1]), "+v"(vh_[1][1]), \
                 "+v"(vl_[2][0]), "+v"(vh_[2][0]), "+v"(vl_[2][1]), "+v"(vh_[2][1]), "+v"(vl_[3][0]), "+v"(vh_[3][0]), "+v"(vl_[3][1]), "+v"(vh_[3][1]) :: "memory"); \
    _Pragma("unroll") for (int s = 0; s < 4; ++s) _Pragma("unroll") for (int d = 0; d < 2; ++d) o[d] = MFMA32(VFRAG(vl_[s][d], vh_[s][d]), pb_[s], o[d]); \
    if ((j) + 3 < NT) { AT_WAITBAR(2); } else AT_WAITBAR(0); \
  } while (0)
#define VGRP(vl, vh, s, va) do { VTR(vl[0], va[0], (16 * (s)) * VROW); VTR(vh[0], va[0], (16 * (s) + 8) * VROW); VTR(vl[1], va[1], (16 * (s)) * VROW); VTR(vh[1], va[1], (16 * (s) + 8) * VROW); \
    VTR(vl[2], va[2], (16 * (s)) * VROW); VTR(vh[2], va[2], (16 * (s) + 8) * VROW); VTR(vl[3], va[3], (16 * (s)) * VROW); VTR(vh[3], va[3], (16 * (s) + 8) * VROW); } while (0)
#define VWAIT(N, vl, vh) asm volatile("s_waitcnt lgkmcnt(" #N ")" : "+v"(vl[0]), "+v"(vh[0]), "+v"(vl[1]), "+v"(vh[1]), "+v"(vl[2]), "+v"(vh[2]), "+v"(vl[3]), "+v"(vh[3]) :: "memory")
#define STEP_C(C0, C1, j) do { \
    if ((j) + 2 < NT) { DMA_K((j) + 2); DMA_V((j) + 2); } \
    QK(C0, C1, (j)); \
    s16x4 xl_[4], xh_[4], yl_[4], yh_[4]; unsigned va_[4]; \
    _Pragma("unroll") for (int d = 0; d < 4; ++d) va_[d] = lds0 + ((j) % 3) * VT_B + vo[d]; \
    VGRP(xl_, xh_, 0, va_); VGRP(yl_, yh_, 1, va_); \
    SOFTMAX(C0, C1, C0, C1, j, false) \
    VWAIT(8, xl_, xh_); \
    _Pragma("unroll") for (int d = 0; d < 4; ++d) o[d] = MFMA32(VFRAG(xl_[d], xh_[d]), pb_[0], o[d]); \
    VGRP(xl_, xh_, 2, va_); \
    VWAIT(8, yl_, yh_); \
    _Pragma("unroll") for (int d = 0; d < 4; ++d) o[d] = MFMA32(VFRAG(yl_[d], yh_[d]), pb_[1], o[d]); \
    VGRP(yl_, yh_, 3, va_); \
    VWAIT(8, xl_, xh_); \
    _Pragma("unroll") for (int d = 0; d < 4; ++d) o[d] = MFMA32(VFRAG(xl_[d], xh_[d]), pb_[2], o[d]); \
    VWAIT(0, yl_, yh_); \
    _Pragma("unroll") for (int d = 0; d < 4; ++d) o[d] = MFMA32(VFRAG(yl_[d], yh_[d]), pb_[3], o[d]); \
    if ((j) + 2 < NT) { AT_WAITBAR(4); } else AT_WAITBAR(0); \
  } while (0)
  f32x16 pA0, pA1;
  if (MODE == 0) {
    f32x16 pB0, pB1;
    QK(pA0, pA1, 0);
    AT_WAITBAR(0);
    for (int j = 0; j < NT; j += 2) {
      STEP_A(pA0, pA1, pB0, pB1, j);
      STEP_A(pB0, pB1, pA0, pA1, j + 1);
    }
  } else {
    for (int j = 0; j < NT; ++j) STEP_C(pA0, pA1, j);
  }
#undef STEP_A
#undef STEP_C
#undef SOFTMAX
#undef VGRP
#undef VWAIT
#undef VTR
#undef VFRAG
#undef QK
#undef DMA_K
#undef DMA_V
#undef TILE_ROW
  __builtin_amdgcn_s_setprio(0);
  const float lt = xhalf_sum(lrun);
  const float inv = 1.0f / lt;
  if (MODE == 0) {
    bf16_t* zrow = SGP + (size_t)qrow * 1536 + 64 * (4 * hg + (w & 3));
#pragma unroll
    for (int d = 0; d < NDB; ++d)
#pragma unroll
      for (int gq = 0; gq < 4; ++gq) {
        bf16_t* p = zrow + 32 * d + 8 * gq + 4 * h;
        const f32x4 g = unpack4(*(const u32x2*)p);
        const f32x4 v = {o[d][4 * gq] * inv * g[0], o[d][4 * gq + 1] * inv * g[1], o[d][4 * gq + 2] * inv * g[2], o[d][4 * gq + 3] * inv * g[3]};
        *(u32x2*)p = pack4(v);
      }
  } else {
    LAS float* xch = (LAS float*)(lds + XCH_OFF) + (size_t)qsub * (NDB * 16 * 64) + lane;
    const float lam = ((const float*)(P.ws + WS_LAM))[l];
    if (kidx == 1) {
      const float f = inv * lam;
#pragma unroll
      for (int d = 0; d < NDB; ++d)
#pragma unroll
        for (int i = 0; i < 16; ++i) xch[(d * 16 + i) * 64] = o[d][i] * f;
    }
    __syncthreads();
    if (kidx == 0) {
      float ss = 0.f;
#pragma unroll
      for (int d = 0; d < NDB; ++d)
#pragma unroll
        for (int i = 0; i < 16; ++i) { const float y = o[d][i] * inv - xch[(d * 16 + i) * 64]; o[d][i] = y; ss += y * y; }
      ss += __shfl_xor(ss, 32);
      const float rs = (1.0f / sqrtf(ss * (1.0f / 128.0f) + EPS)) * (1.0f - P.lam_init[l]);
      const float* sub = P.subln + l * 128;
      bf16_t* zrow = SGP + (size_t)qrow * 1536 + 1024 + 128 * hg;
#pragma unroll
      for (int d = 0; d < NDB; ++d)
#pragma unroll
        for (int gq = 0; gq < 4; ++gq) {
          const int dv = 32 * d + 8 * gq + 4 * h;
          const f32x4 g = unpack4(*(const u32x2*)(zrow + dv)), sw = *(const f32x4*)(sub + dv);
          const f32x4 v = {o[d][4 * gq] * rs * sw[0] * g[0], o[d][4 * gq + 1] * rs * sw[1] * g[1], o[d][4 * gq + 2] * rs * sw[2] * g[2], o[d][4 * gq + 3] * rs * sw[3] * g[3]};
          *(u32x2*)(zrow + dv) = pack4(v);
        }
    }
    __syncthreads();
  }
}

DI void attn_phase(const Params& P, LAS unsigned char* lds, int l, bool last) {
  const int G = gridDim.x, bx = blockIdx.x;
  const int v = (G % 8 == 0) ? (bx % 8) * (G / 8) + bx / 8 : bx;
  const int nunits = last ? 2048 : 2304;
  for (int k = 0; k < 9; ++k) {
    const int uid = k < 8 ? ((k & 1) ? 1024 : 0) + v + 256 * (k >> 1) : 2048 + v;
    if (uid >= nunits) break;
    if (uid < 1024) attn_unit<1>(P, lds, l, 15 - (uid >> 6), (uid >> 4) & 3, uid & 15, false);
    else if (uid < 2048) { const int u = uid - 1024; attn_unit<0>(P, lds, l, 15 - (u >> 6), (u >> 5) & 1, u & 31, false); }
    else if (uid < 2176) { const int u = uid - 2048; attn_unit<1>(P, lds, l, u >> 3, (u >> 1) & 3, u & 1, true); }
    else { const int u = uid - 2176; attn_unit<0>(P, lds, l, u >> 3, (u >> 2) & 1, u & 3, true); }
  }
  const bf16_t* U = (const bf16_t*)(P.ws + WS_U);
  bf16_t* SGP = (bf16_t*)(P.ws + WS_SGP);
  const float* cw = P.convw + (size_t)l * 3 * 512;
  const int rows = last ? MLAT : MTOT;
  const int nth = G * NTHREADS;
  const int ctid = bx * NTHREADS + opaque_tid();
  const int ch = (ctid & 63) * 8;
  f32x4 cwv[3][2];
#pragma unroll
  for (int t = 0; t < 3; ++t) { cwv[t][0] = *(const f32x4*)(cw + 512 * t + ch); cwv[t][1] = *(const f32x4*)(cw + 512 * t + ch + 4); }
  for (int it = ctid; it < (rows / 8) * 64; it += nth) {
    const int r0 = (it >> 6) * 8;
    const bool lat = r0 < MLAT;
    const int s0 = lat ? (r0 & (SEQ - 1)) : ((r0 - MLAT) & (CTXL - 1)), slen = lat ? SEQ : CTXL;
    const u32x4 z = {0u, 0u, 0u, 0u};
    u32x4 uu[10], pr[8];
    uu[0] = s0 > 0 ? *(const u32x4*)(U + (size_t)(r0 - 1) * 512 + ch) : z;
#pragma unroll
    for (int i = 0; i < 8; ++i) uu[1 + i] = *(const u32x4*)(U + (size_t)(r0 + i) * 512 + ch);
    uu[9] = (s0 + 8 < slen) ? *(const u32x4*)(U + (size_t)(r0 + 8) * 512 + ch) : z;
#pragma unroll
    for (int i = 0; i < 8; ++i) pr[i] = *(const u32x4*)(SGP + (size_t)(r0 + i) * 1536 + 512 + ch);
#pragma unroll
    for (int i = 0; i < 8; ++i) {
      u32x4 res;
#pragma unroll
      for (int e = 0; e < 4; ++e) {
        const int k = (2 * e) >> 2, i0 = (2 * e) & 3;
        const float a = cwv[0][k][i0] * __uint_as_float(uu[i][e] << 16) + cwv[1][k][i0] * __uint_as_float(uu[i + 1][e] << 16) + cwv[2][k][i0] * __uint_as_float(uu[i + 2][e] << 16);
        const float bq = cwv[0][k][i0 + 1] * __uint_as_float(uu[i][e] & 0xffff0000u) + cwv[1][k][i0 + 1] * __uint_as_float(uu[i + 1][e] & 0xffff0000u) + cwv[2][k][i0 + 1] * __uint_as_float(uu[i + 2][e] & 0xffff0000u);
        res[e] = pk2(a * __uint_as_float(pr[i][e] << 16), bq * __uint_as_float(pr[i][e] & 0xffff0000u));
      }
      *(u32x4*)(SGP + (size_t)(r0 + i) * 1536 + 512 + ch) = res;
    }
  }
}

__global__ void __launch_bounds__(NTHREADS, 2) fwd_megakernel(Params P) {
  extern __shared__ __attribute__((aligned(16))) unsigned char lds_raw[];
  LAS unsigned char* lds = (LAS unsigned char*)lds_raw;
  cg::grid_group grid = cg::this_grid();
  const int G = gridDim.x;
  volatile LAS unsigned* xst = (volatile LAS unsigned*)(lds + LDS_BYTES - 64);
  if (threadIdx.x < 2) xst[threadIdx.x] = 0u;
  __syncthreads();
  const XcdBarrier xbar = xcd_barrier_post((unsigned*)(P.ws + WS_BAR), xst);
  phase0(P, lds);
  grid.sync();
#pragma unroll 1
  for (int l = 0; l < DEPTH; ++l) {
    const bool last = (l == DEPTH - 1);
    norm_phase(P, l);
    xcd_barrier(xbar);
#define MAKE_EGI(OFF) EpiGI egi{(bf16_t*)(P.ws + WS_QA), (bf16_t*)(P.ws + WS_KA), (bf16_t*)(P.ws + WS_VA), (bf16_t*)(P.ws + WS_QC), (bf16_t*)(P.ws + WS_KC), (bf16_t*)(P.ws + WS_VC), \
              (bf16_t*)(P.ws + WS_U), (bf16_t*)(P.ws + WS_SGP), (bf16_t*)(P.ws + WS_G), P.qn + l * 64, P.kn + l * 64, (const float*)(P.ws + WS_ROPE), OFF}; \
    const bf16_t* WinT = (const bf16_t*)(P.ws + WS_WIN) + (size_t)l * PROJ * 1024
    {
      MAKE_EGI(0);
      pg8::Gemm g{(const bf16_t*)(P.ws + WS_H), WinT, MTOT, GI1_TILES * 256, 1024, 16};
      OrderGI S; S.base.init(last ? MLAT : MTOT, GI1_TILES * 256, G, (int)blockIdx.x); S.extra = last ? 5 * (MCTX / 256) : 0;
      pg8::gemm_phase<EpiGI, OrderGI, true, true, false>(lds, g, S, egi);
    }
    xcd_barrier(xbar);
    attn_phase(P, lds, l, last);
    xcd_barrier(xbar);
    const int Mrows = last ? MLAT : MTOT;
    {
      MAKE_EGI(GI1_TILES);
      pg8::Gemm g{(const bf16_t*)(P.ws + WS_H), WinT + (size_t)GI1_TILES * 256 * 1024, Mrows, GI2_TILES * 256, 1024, 16};
      OrderGI S; S.base.init(Mrows, GI2_TILES * 256, G, (int)blockIdx.x); S.extra = 0;
      pg8::gemm_phase<EpiGI, OrderGI, true, true, false>(lds, g, S, egi);
    }
    xcd_barrier(xbar);
#define RUN_GM(SM) do { const EpiGM egm{(const unsigned char*)(P.ws + WS_G), (bf16_t*)(P.ws + WS_H)}; \
      const pg8::Gemm ggm{(const bf16_t*)(P.ws + WS_SGP), (const bf16_t*)(P.ws + WS_WM) + (size_t)l * 1024 * 1536, Mrows, 1024, 1536, 8}; \
      pg8::gemm_phase<EpiGM, ListOrder<true>, true, true, true>(lds, ggm, SM, egm); } while (0)
#define RUN_GO(SO) do { const EpiGO ego{l == 0 ? P.x : (const float*)P.out, l == 0 ? P.ctx : (const float*)(P.ws + WS_XC), P.out, (float*)(P.ws + WS_XC), (const float*)(P.ws + WS_MOD) + (size_t)l * 17 * 3072}; \
      const pg8::Gemm ggo{(const bf16_t*)(P.ws + WS_H), (const bf16_t*)(P.ws + WS_WO) + (size_t)l * 1024 * 1024, Mrows, 1024, 1024, 16}; \
      pg8::gemm_phase<EpiGO, ListOrder<false>, true, true, false>(lds, ggo, SO, ego); } while (0)
    {
      ListOrder<true> Sm; Sm.clear();
      pg8::StaticOrder B; B.init(Mrows, 1024, G, (int)blockIdx.x); pg8::Unit t;
      if (B.next(0, t)) { Sm.set0(t.pm, t.pn); if (B.next(1, t)) Sm.set1(t.pm, t.pn); }
      RUN_GM(Sm);
    }
    xcd_barrier(xbar);
    {
      ListOrder<true> Sm; Sm.clear();
      ListOrder<false> So; So.clear();
      pg8::StaticOrder B; B.init(Mrows, 1024, G, (int)blockIdx.x); pg8::Unit t;
      if (last) { if (B.next(0, t)) { So.set0(t.pm, t.pn); if (B.next(1, t)) So.set1(t.pm, t.pn); } }
      else if ((int)blockIdx.x < 64) { if (B.next(2, t)) Sm.set0(t.pm, t.pn); }
      else {
        const int q = ((int)blockIdx.x & 7) * 24 + (((int)blockIdx.x >> 3) - 8);
        { int pm = q >> 2;
#pragma unroll
          for (int x = 0; x < 8; ++x) if (pm >= late_base(x)) pm += 8;
          So.set0(pm, q & 3); }
        if (q + 192 < 320) { int pm = (q + 192) >> 2;
#pragma unroll
          for (int x = 0; x < 8; ++x) if (pm >= late_base(x)) pm += 8;
          So.set1(pm, (q + 192) & 3); }
      }
      RUN_GM(Sm);
      RUN_GO(So);
    }
    if (!last) {
      xcd_barrier(xbar);
      ListOrder<false> So; So.clear();
      const int q = ((int)blockIdx.x & 7) * 32 + ((int)blockIdx.x >> 3); if (q < 256) { const int k = q >> 2; So.set0(late_base(k >> 3) + (k & 7), q & 3); }
      RUN_GO(So);
    }
    xcd_barrier(xbar);
  }
  final_phase(P);
}

extern "C" void kernel_launch(void* const* d_in, const int* in_sizes, int n_in, void* d_out, int out_size, void* d_ws, size_t ws_size, hipStream_t stream) {
  static int grid_blocks = 0;
  if (grid_blocks == 0) {
    if (n_in != 20 || out_size != MLAT * DM || ws_size < WS_END) { fprintf(stderr, "kernel_launch: unexpected problem (n_in %d, out %d, ws %zu)\n", n_in, out_size, ws_size); grid_blocks = -1; return; }
    int dev = 0, cus = 0, per_cu = 0;
    hipGetDevice(&dev);
    hipDeviceGetAttribute(&cus, hipDeviceAttributeMultiprocessorCount, dev);
    hipFuncSetAttribute((const void*)fwd_megakernel, hipFuncAttributeMaxDynamicSharedMemorySize, LDS_BYTES);
    hipOccupancyMaxActiveBlocksPerMultiprocessor(&per_cu, (const void*)fwd_megakernel, NTHREADS, LDS_BYTES);
    if (per_cu < 1) per_cu = 1;
    grid_blocks = cus * per_cu;
    if (grid_blocks % 8 != 0 || grid_blocks <= 0) grid_blocks = (grid_blocks / 8) * 8;
    if (grid_blocks != 256) { fprintf(stderr, "kernel_launch: this kernel's merge/out GEMM unit lists are laid out for exactly 256 workgroups (one per CU of a 256-CU device); got %d; nothing launched\n", grid_blocks); grid_blocks = -1; return; }
    (void)hipGetLastError();
  }
  if (grid_blocks <= 0) return;
  Params p{};
  const float** pp = (const float**)&p;
  for (int i = 0; i < 20; ++i) pp[i] = (const float*)d_in[i];
  p.out = (float*)d_out; p.ws = (unsigned char*)d_ws;
  p.lam_init[0] = 0.2f; p.lam_init[1] = 0.35550907f; p.lam_init[2] = 0.47071302f; p.lam_init[3] = 0.55605821f;
  hipMemsetAsync((char*)d_ws + WS_BAR, 0, 16384, stream);
  void* args[] = {&p};
  hipError_t e = hipLaunchCooperativeKernel((const void*)fwd_megakernel, dim3(grid_blocks), dim3(NTHREADS), args, LDS_BYTES, stream);
  if (e != hipSuccess) fprintf(stderr, "cooperative launch failed: %s (grid %d)\n", hipGetErrorString(e), grid_blocks);
}
```

```cpp
#include <hip/hip_runtime.h>
#include <hip/hip_cooperative_groups.h>
#include <cstdio>
#include <cstdint>
namespace cg = cooperative_groups;
namespace pg8 {
#define PG8_LAS __attribute__((address_space(3)))
typedef unsigned short bf16_t;
typedef short bf16x8 __attribute__((ext_vector_type(8)));
typedef float f32x4 __attribute__((ext_vector_type(4)));
typedef unsigned u32x4 __attribute__((ext_vector_type(4)));
constexpr int BM = 256, BK = 64, HALF = 128, HTB = HALF * BK * 2  , STAGE_BYTES = 8 * HTB, NXCD = 8, WGM = 8;

__host__ __device__ __forceinline__ int lds_byte(int r, int c) { const int st = (r >> 4) * 2 + (c >> 5), rr = r & 15, cc = c & 31, ob = rr * 64 + cc * 2; return st * 1024 + (ob ^ (((ob >> 9) & 1) << 5)); }
__host__ __device__ __forceinline__ void stage_rc(int b, int& R, int& C) { const int st = b / 1024, sb = b % 1024, swz = sb ^ (((sb >> 9) & 1) << 5); R = (st >> 1) * 16 + swz / 64; C = (st & 1) * 32 + (swz % 64) / 2; }
__host__ __device__ __forceinline__ int perm32(int rho) { const int n = rho >> 4, i = rho & 15; return 8 * (i >> 2) + 4 * n + (i & 3); }

struct Unit { int pm, pn, kb, br; };
struct Gemm { const bf16_t* A; const bf16_t* Bt; int M, N, K, nt; };

struct StaticOrder {
    int nM, nN, nwg, G, c;
    __host__ __device__ void init(int M, int N, int G_, int c_) { nM = M / BM; nN = N / BM; nwg = nM * nN; G = G_; c = c_; }
    __host__ __device__ bool next(int i, Unit& u) const {
        const long L = (long)i * G + c; if (L >= nwg) return false;
        int wgid = (int)L; { const int q = nwg / NXCD, r = nwg % NXCD, xcd = wgid % NXCD, off = wgid / NXCD; wgid = (xcd < r ? xcd * (q + 1) : r * (q + 1) + (xcd - r) * q) + off; }
        const int nig = WGM * nN, gid = wgid / nig, fm = gid * WGM, gsz = (nM - fm) < WGM ? (nM - fm) : WGM;
        u.pm = fm + ((wgid % nig) % gsz); u.pn = (wgid % nig) / gsz; u.kb = 0; u.br = 0; return true;
    }
    __device__ __forceinline__ void a_ready(const Unit&) const {}
    __device__ __forceinline__ void done(const Unit&) const {}
};

template <class Epi, class Sched, bool ALIGN_EPI = false, bool SP2 = false, bool HOOK = false>
__device__ __forceinline__ void gemm_phase(PG8_LAS unsigned char* lds, const Gemm g, const Sched& S, const Epi& E) {
    int tid_ = threadIdx.x; asm volatile("" : "+v"(tid_));
    const int tid = tid_, wid = __builtin_amdgcn_readfirstlane(tid >> 6), lane = tid & 63, wr = wid >> 2, wc = wid & 3, fr = lane & 15, fq = lane >> 4;
    const int K = g.K, nt = g.nt;
    unsigned voffA[2], voffB[2];
#pragma unroll
    for (int i = 0; i < 2; ++i) { int R, C; stage_rc(tid * 16 + i * 8192, R, C); const int Rb = Epi::PERM ? ((R & ~31) + perm32(R & 31)) : R;
        voffA[i] = (unsigned)(R * K + C) * 2u; voffB[i] = (unsigned)(Rb * K + C) * 2u; }
    const size_t kstep = (size_t)(BK * 2);
    const size_t hstep = (size_t)HALF * K * 2;
    const size_t tstep = 2 * hstep;
    const unsigned ldsw = (unsigned)wid * 1024u;
    const int aoff = lds_byte(wr * 64 + fr, fq * 8), boff = lds_byte(wc * 32 + fr, fq * 8);
#define PG8_SA(b, h) (((b) * 2 + (h)) * HTB)
#define PG8_SB(b, h) ((4 + (b) * 2 + (h)) * HTB)
#define PG8_STAGE(bufoff, gbase, voff) do { _Pragma("unroll") for (int _i = 0; _i < 2; ++_i) \
        __builtin_amdgcn_global_load_lds((const unsigned*)((const char*)(gbase) + (voff)[_i]), (PG8_LAS unsigned*)(lds + (bufoff) + ldsw + _i * 8192), 16, 0, 0); } while (0)
#define PG8_LDA(dst, b, h) do { _Pragma("unroll") for (int m = 0; m < 4; ++m) _Pragma("unroll") for (int k = 0; k < 2; ++k) dst[m][k] = *(const PG8_LAS bf16x8*)(lds + PG8_SA(b, h) + aoff + m * 2048 + k * 1024); } while (0)
#define PG8_LDB(dst, b, h) do { _Pragma("unroll") for (int n = 0; n < 2; ++n) _Pragma("unroll") for (int k = 0; k < 2; ++k) dst[n][k] = *(const PG8_LAS bf16x8*)(lds + PG8_SB(b, h) + boff + n * 2048 + k * 1024); } while (0)
#define PG8_MMA(ai, bj, At, Bt) do { __builtin_amdgcn_s_setprio(1); _Pragma("unroll") for (int m = 0; m < 4; ++m) _Pragma("unroll") for (int n = 0; n < 2; ++n) _Pragma("unroll") for (int k = 0; k < 2; ++k) \
        acc[ai][bj][m][n] = __builtin_amdgcn_mfma_f32_16x16x32_bf16(Bt[n][k], At[m][k], acc[ai][bj][m][n], 0, 0, 0); __builtin_amdgcn_s_setprio(0); } while (0)
#define PG8_WAIT_V(n) asm volatile("s_waitcnt vmcnt(" #n ")" ::: "memory")
#define PG8_WAIT_L(n) asm volatile("s_waitcnt lgkmcnt(" #n ")" ::: "memory")
#define PG8_BAR __builtin_amdgcn_s_barrier()
#define PG8_SCHED __builtin_amdgcn_sched_barrier(0)
    Unit cur, nxt; int ui = 0;
    if (!S.next(0, cur)) return;
    f32x4 acc[2][2][4][2];
#pragma unroll
    for (int a = 0; a < 2; ++a)
#pragma unroll
        for (int b = 0; b < 2; ++b)
#pragma unroll
            for (int m = 0; m < 4; ++m)
#pragma unroll
                for (int n = 0; n < 2; ++n) acc[a][b][m][n] = (f32x4){0.f, 0.f, 0.f, 0.f};
    bf16x8 At[4][2], B0[2][2], B1[2][2];
    const char* cA = (const char*)g.A + (size_t)cur.pm * tstep + cur.kb; const char* cB = (const char*)g.Bt + (size_t)cur.pn * tstep + cur.kb;
    S.a_ready(cur);
    if constexpr (SP2) {
        PG8_STAGE(PG8_SB(0, 0), cB, voffB); PG8_STAGE(PG8_SB(0, 1), cB + hstep, voffB); PG8_STAGE(PG8_SA(0, 0), cA, voffA); PG8_STAGE(PG8_SA(0, 1), cA + hstep, voffA);
        if (wr == 1) PG8_BAR;
        PG8_WAIT_V(2); PG8_BAR;
        PG8_STAGE(PG8_SB(1, 0), cB + kstep, voffB); PG8_STAGE(PG8_SA(1, 0), cA + kstep, voffA); PG8_STAGE(PG8_SB(1, 1), cB + hstep + kstep, voffB);
        PG8_WAIT_V(6); PG8_BAR;
    } else {
        PG8_STAGE(PG8_SB(0, 0), cB, voffB); PG8_STAGE(PG8_SA(0, 0), cA, voffA); PG8_STAGE(PG8_SB(0, 1), cB + hstep, voffB); PG8_STAGE(PG8_SA(0, 1), cA + hstep, voffA);
        if (wr == 1) PG8_BAR;
        PG8_WAIT_V(4); PG8_BAR;
        PG8_STAGE(PG8_SB(1, 0), cB + kstep, voffB); PG8_STAGE(PG8_SA(1, 0), cA + kstep, voffA); PG8_STAGE(PG8_SB(1, 1), cB + hstep + kstep, voffB);
        PG8_WAIT_V(6); PG8_BAR;
    }
    for (;;) {
        const bool has_next = S.next(ui + 1, nxt);
        const char* nA = has_next ? (const char*)g.A + (size_t)nxt.pm * tstep + nxt.kb : cA; const char* nB = has_next ? (const char*)g.Bt + (size_t)nxt.pn * tstep + nxt.kb : cB;
        for (int t = 0; t < nt; t += 2) {
            const bool last = (t == nt - 2);
            const char* a1 = cA + (size_t)(t + 1) * kstep;
            const char* a2 = last ? nA : cA + (size_t)(t + 2) * kstep; const char* b2 = last ? nB : cB + (size_t)(t + 2) * kstep;
            const char* a3 = a2 + kstep; const char* b3 = b2 + kstep;
            if (last && has_next) S.a_ready(nxt);
            if constexpr (SP2) {
            PG8_LDB(B0, 0, 0); PG8_LDB(B1, 0, 1); PG8_SCHED; PG8_LDA(At, 0, 0); PG8_STAGE(PG8_SA(1, 1), a1 + hstep, voffA);
            PG8_WAIT_V(8); PG8_WAIT_L(0); PG8_BAR; PG8_MMA(0, 0, At, B0); PG8_MMA(0, 1, At, B1); PG8_BAR; PG8_SCHED;
            PG8_LDA(At, 0, 1); PG8_STAGE(PG8_SB(0, 0), b2, voffB); PG8_STAGE(PG8_SB(0, 1), b2 + hstep, voffB); PG8_STAGE(PG8_SA(0, 0), a2, voffA);
            PG8_WAIT_V(8); PG8_WAIT_L(0); PG8_BAR; PG8_MMA(1, 0, At, B0); PG8_MMA(1, 1, At, B1); PG8_BAR; PG8_SCHED;
            PG8_LDB(B0, 1, 0); PG8_LDB(B1, 1, 1); PG8_SCHED; PG8_LDA(At, 1, 0); PG8_STAGE(PG8_SA(0, 1), a2 + hstep, voffA);
            PG8_WAIT_V(8); PG8_WAIT_L(0); PG8_BAR; PG8_MMA(0, 0, At, B0); PG8_MMA(0, 1, At, B1); PG8_BAR; PG8_SCHED;
            PG8_LDA(At, 1, 1); PG8_STAGE(PG8_SB(1, 0), b3, voffB); PG8_STAGE(PG8_SB(1, 1), b3 + hstep, voffB); PG8_STAGE(PG8_SA(1, 0), a3, voffA);
            PG8_WAIT_V(8); PG8_WAIT_L(0); PG8_BAR; PG8_MMA(1, 0, At, B0); PG8_MMA(1, 1, At, B1); PG8_BAR; PG8_SCHED;
            } else {
            PG8_LDB(B0, 0, 0); PG8_SCHED; PG8_LDA(At, 0, 0); PG8_STAGE(PG8_SA(1, 1), a1 + hstep, voffA);
            PG8_WAIT_L(8); PG8_BAR; PG8_WAIT_L(0); PG8_MMA(0, 0, At, B0); PG8_BAR; PG8_SCHED;
            PG8_LDB(B1, 0, 1); PG8_STAGE(PG8_SB(0, 0), b2, voffB);
            PG8_BAR; PG8_WAIT_L(0); PG8_MMA(0, 1, At, B1); PG8_BAR;
            PG8_LDA(At, 0, 1); PG8_STAGE(PG8_SA(0, 0), a2, voffA);
            PG8_BAR; PG8_WAIT_L(0); PG8_MMA(1, 0, At, B0); PG8_BAR; PG8_SCHED;
            PG8_STAGE(PG8_SB(0, 1), b2 + hstep, voffB);
            PG8_WAIT_V(6); PG8_BAR; PG8_MMA(1, 1, At, B1); PG8_BAR;
            PG8_LDB(B0, 1, 0); PG8_SCHED; PG8_LDA(At, 1, 0); PG8_STAGE(PG8_SA(0, 1), a2 + hstep, voffA);
            PG8_WAIT_L(8); PG8_BAR; PG8_WAIT_L(0); PG8_MMA(0, 0, At, B0); PG8_BAR; PG8_SCHED;
            PG8_LDB(B1, 1, 1); PG8_STAGE(PG8_SB(1, 0), b3, voffB);
            PG8_BAR; PG8_WAIT_L(0); PG8_MMA(0, 1, At, B1); PG8_BAR;
            PG8_LDA(At, 1, 1); PG8_STAGE(PG8_SA(1, 0), a3, voffA);
            PG8_BAR; PG8_WAIT_L(0); PG8_MMA(1, 0, At, B0); PG8_BAR; PG8_SCHED;
            PG8_STAGE(PG8_SB(1, 1), b3 + hstep, voffB);
            PG8_WAIT_V(6); PG8_BAR; PG8_MMA(1, 1, At, B1); PG8_BAR;
            }
        }
        if constexpr (ALIGN_EPI) { if (wr == 0) PG8_BAR; }
        if constexpr (HOOK) { E.sub(acc, cur, wr, wc, fr, fq); S.done(cur); }
        else if constexpr (!Epi::AFTER_DRAIN) { E(acc, cur, wr, wc, fr, fq); S.done(cur); }
        if (!has_next) break;
        if constexpr (!HOOK)
#pragma unroll
        for (int a = 0; a < 2; ++a)
#pragma unroll
            for (int b = 0; b < 2; ++b)
#pragma unroll
                for (int m = 0; m < 4; ++m)
#pragma unroll
                    for (int n = 0; n < 2; ++n) acc[a][b][m][n] = (f32x4){0.f, 0.f, 0.f, 0.f};
        cur = nxt; cA = nA; cB = nB; ++ui;
        if constexpr (ALIGN_EPI) { if (wr == 1) PG8_BAR; }
    }
    PG8_WAIT_V(0);
    if constexpr (!ALIGN_EPI) { if (wr == 0) PG8_BAR; }
    PG8_BAR;
    if constexpr (Epi::AFTER_DRAIN) { E.fused(acc, cur, wr, wc, fr, fq, lds, wid, lane); S.done(cur); }
#undef PG8_SA
#undef PG8_SB
#undef PG8_STAGE
#undef PG8_LDA
#undef PG8_LDB
#undef PG8_MMA
#undef PG8_WAIT_V
#undef PG8_WAIT_L
#undef PG8_BAR
#undef PG8_SCHED
}
}
#define LAS __attribute__((address_space(3)))
#define XB_TMO      128
#define XB_XCNT(j)  (256  + 64 * (j))
#define XB_XSUB(j)  (1280 + 64 * (j))
#define XB_XGEN(j)  (2304 + 64 * (j))
#define XB_TOP      3328
#define XB_TOPGEN   3392
#define XCD_BAR_WORDS 3456
#define XB_SPIN_CAP (1u << 18)

__device__ __forceinline__ unsigned xb_ld(unsigned* p)              { return __hip_atomic_load(p, __ATOMIC_RELAXED, __HIP_MEMORY_SCOPE_AGENT); }
__device__ __forceinline__ unsigned xb_add(unsigned* p, unsigned v) { return __hip_atomic_fetch_add(p, v, __ATOMIC_RELAXED, __HIP_MEMORY_SCOPE_AGENT); }
__device__ __forceinline__ unsigned xb_xcc_id() { return (unsigned)__builtin_amdgcn_s_getreg((3 << 11) | 20) & 0xFu; }
#define XB_SPIN(cond, bar) do { unsigned _sp = 0; while (cond) { __builtin_amdgcn_s_sleep(1); \
    if ((++_sp & 255u) == 0u) { if (xb_ld(&(bar)[XB_TMO])) break; if (_sp > XB_SPIN_CAP) { atomicAdd(&(bar)[XB_TMO], 1u); break; } } } } while (0)

struct XcdBarrier {
    unsigned* bar; unsigned x;
    volatile LAS unsigned* st;
};

__device__ __forceinline__ XcdBarrier xcd_barrier_post(unsigned* bar, volatile LAS unsigned* st) {
    XcdBarrier b; b.bar = bar; b.x = xb_xcc_id(); b.st = st;
    if (threadIdx.x == 0) (void)xb_add(&bar[XB_XCNT(b.x)], 1u);
    return b;
}
__device__ __forceinline__ void xcd_barrier_complete(unsigned* bar, unsigned x, unsigned& nloc, unsigned& nx) {
    const unsigned G = gridDim.x * gridDim.y * gridDim.z;
    unsigned sum, cnt, mine, sp = 0u;
    for (;;) {
        sum = 0u; cnt = 0u; mine = 0u;
#pragma unroll
        for (unsigned j = 0; j < 16; ++j) { const unsigned c = xb_ld(&bar[XB_XCNT(j)]); sum += c; cnt += (c > 0u) ? 1u : 0u; mine = (j == x) ? c : mine; }
        if (sum == G) break;
        __builtin_amdgcn_s_sleep(1);
        if ((++sp & 255u) == 0u) { if (xb_ld(&bar[XB_TMO])) break; if (sp > XB_SPIN_CAP) { atomicAdd(&bar[XB_TMO], 1u); break; } }
    }
    nloc = mine > 0u ? mine : 1u; nx = cnt > 0u ? cnt : 1u;
}

__device__ __forceinline__ void xcd_barrier(const XcdBarrier& b) {
    asm volatile("s_waitcnt vmcnt(0)" ::: "memory");
    __syncthreads();
    if (threadIdx.x == 0) {
        unsigned* bar = b.bar; asm volatile("" : "+s"(bar));
        __builtin_amdgcn_s_waitcnt(0);
        unsigned nloc = b.st[0], nx = b.st[1];
        if (nloc == 0u) { xcd_barrier_complete(bar, b.x, nloc, nx); b.st[0] = nloc; b.st[1] = nx; }
        const unsigned old = xb_add(&bar[XB_XSUB(b.x)], 1u);
        const unsigned gen = old / nloc;
        if (old + 1u == (gen + 1u) * nloc) {
            __builtin_amdgcn_fence(__ATOMIC_RELEASE, "agent");
            asm volatile("s_waitcnt vmcnt(0)" ::: "memory");
            const unsigned og = xb_add(&bar[XB_TOP], 1u);
            const unsigned tg = og / nx;
            if (og + 1u == (tg + 1u) * nx) xb_add(&bar[XB_TOPGEN], 1u);
            else XB_SPIN(xb_ld(&bar[XB_TOPGEN]) == tg, bar);
            __builtin_amdgcn_fence(__ATOMIC_ACQUIRE, "agent");
            xb_add(&bar[XB_XGEN(b.x)], 1u);
            asm volatile("s_waitcnt vmcnt(0)" ::: "memory");
        } else {
            XB_SPIN(xb_ld(&bar[XB_XGEN(b.x)]) == gen, bar);
            __builtin_amdgcn_fence(__ATOMIC_ACQUIRE, "agent");
            asm volatile("s_waitcnt vmcnt(0)" ::: "memory");
        }
    }
    __syncthreads();
}

#define DI __device__ __forceinline__
#define LAS __attribute__((address_space(3)))
typedef unsigned short bf16_t;
typedef short bf16x8 __attribute__((ext_vector_type(8)));
typedef short s16x4 __attribute__((ext_vector_type(4)));
typedef float f32x4 __attribute__((ext_vector_type(4)));
typedef float f32x16 __attribute__((ext_vector_type(16)));
typedef unsigned u32x4 __attribute__((ext_vector_type(4)));
typedef unsigned u32x2 __attribute__((ext_vector_type(2)));
typedef float f32x2_t __attribute__((ext_vector_type(2)));
typedef __bf16 bf16x2_t __attribute__((ext_vector_type(2)));

constexpr int DM = 1024, NBATCH = 16, SEQ = 2048, CTXL = 256, DEPTH = 4;
constexpr int MLAT = NBATCH * SEQ, MCTX = NBATCH * CTXL, MTOT = MLAT + MCTX;
constexpr int PROJ = 8448;
constexpr int GI1_TILES = 21, GI2_TILES = 12;
constexpr float EPS = 1e-6f;
constexpr float QSCALE = 0.125f * 1.4426950408889634f;
constexpr int NTHREADS = 512;
constexpr int LDS_BYTES = 147456;

constexpr size_t MiB = 1u << 20;
constexpr size_t WS_MOD = 0;
constexpr size_t WS_ROPE = 896 * 1024;
constexpr size_t WS_LAM = 960 * 1024;
constexpr size_t WS_BAR = 976 * 1024;
constexpr size_t WS_WIN = 1 * MiB;
constexpr size_t WS_WM = 67 * MiB;
constexpr size_t WS_WO = 79 * MiB;
constexpr size_t WS_XC = 87 * MiB;
constexpr size_t WS_H = 103 * MiB;
constexpr size_t WS_SGP = 175 * MiB;
constexpr size_t WS_R = 283 * MiB;
constexpr size_t WS_G = WS_R;
constexpr size_t WS_QA = WS_R, WS_QC = WS_R + 36 * MiB, WS_KC = WS_R + 72 * MiB, WS_VC = WS_R + 108 * MiB, WS_U = WS_R + 144 * MiB,
                 WS_KA = WS_R + 180 * MiB, WS_VA = WS_R + 189 * MiB;
constexpr size_t WS_END = WS_R + 216 * MiB;

struct Params {
  const float *x, *c, *ctx, *c_ctx, *w_mod, *b_mod, *w_in, *qn, *kn, *convw, *lq1, *lk1, *lq2, *lk2, *subln, *wa, *wb, *wc, *wo, *fnorm;
  float* out; unsigned char* ws; float lam_init[4];
};

DI unsigned pk2(float lo, float hi) { f32x2_t v = {lo, hi}; bf16x2_t b = __builtin_convertvector(v, bf16x2_t); return __builtin_bit_cast(unsigned, b); }
DI u32x2 pack4(f32x4 v) { return (u32x2){pk2(v[0], v[1]), pk2(v[2], v[3])}; }
DI f32x4 unpack4(u32x2 w) { return (f32x4){__uint_as_float(w.x << 16), __uint_as_float(w.x & 0xffff0000u), __uint_as_float(w.y << 16), __uint_as_float(w.y & 0xffff0000u)}; }
DI float fexp2(float x) { return __builtin_amdgcn_exp2f(x); }
DI float frcp(float x) { return __builtin_amdgcn_rcpf(x); }
DI float sigmoidf_(float x) { return frcp(1.0f + fexp2(-1.4426950408889634f * x)); }
DI float siluf_(float x) { return x * sigmoidf_(x); }
DI int opaque_tid() { int t = threadIdx.x; asm volatile("" : "+v"(t)); return t; }
DI float wave_sum(float v) {
#pragma unroll
  for (int o = 1; o < 64; o <<= 1) v += __shfl_xor(v, o);
  return v;
}

DI int logical_col(int p) {
  const int pn = p >> 8, pc = p & 255;
  const int bj = pc >> 7, wc = (pc >> 5) & 3, e32 = pc & 31, n = (pc >> 4) & 1, e16 = pc & 15;
  if (pn <= 2) return 256 * pn + 64 * wc + 32 * bj + e32;
  if (pn <= 10) return 1280 + 512 * (2 * bj + n) + 64 * (pn - 3) + 16 * wc + e16;
  if (pn <= 14) return 3328 + 256 * (pn - 11) + 64 * wc + 32 * bj + e32;
  if (pn <= 16) return 4352 + 256 * (pn - 15) + pc;
  if (pn <= 18) return 768 + 256 * (pn - 17) + pc;
  if (pn <= 20) return 4864 + 256 * (pn - 19) + pc;
  return 5376 + 256 * (pn - 21) + 128 * bj + 32 * wc + 8 * ((pc >> 2) & 3) + 4 * n + (pc & 3);
}

struct EpiGI {
  static constexpr bool PERM = false, AFTER_DRAIN = false;
  bf16_t *Qa, *Ka, *Va, *Qc, *Kc, *Vc, *U, *SGP, *G; const float *qn, *kn, *rope; int pn_off;

  DI void head_tile(const pg8::f32x4 (&acc)[2][2][4][2], int row0, int fq, bool donorm, const float* gw, bf16_t* dst, int pitch, int dcol, float scale, bool rope_on) const {
#pragma unroll
    for (int ai = 0; ai < 2; ++ai)
#pragma unroll
      for (int m = 0; m < 4; ++m) {
        const int row = row0 + 128 * ai + 16 * m;
        f32x4 v[2][2];
#pragma unroll
        for (int bj = 0; bj < 2; ++bj)
#pragma unroll
          for (int n = 0; n < 2; ++n) v[bj][n] = acc[ai][bj][m][n];
        if (donorm) {
          float ss = 0.f;
#pragma unroll
          for (int bj = 0; bj < 2; ++bj)
#pragma unroll
            for (int n = 0; n < 2; ++n) ss += (v[bj][n][0] * v[bj][n][0] + v[bj][n][1] * v[bj][n][1]) + (v[bj][n][2] * v[bj][n][2] + v[bj][n][3] * v[bj][n][3]);
          ss += __shfl_xor(ss, 16); ss += __shfl_xor(ss, 32);
          const float rs = 1.0f / sqrtf(ss * (1.0f / 64.0f) + EPS);
#pragma unroll
          for (int bj = 0; bj < 2; ++bj)
#pragma unroll
            for (int n = 0; n < 2; ++n) v[bj][n] = v[bj][n] * rs * *(const f32x4*)(gw + 32 * bj + 16 * n + 4 * fq);
        }
        if (rope_on) {
          const int s = row & (SEQ - 1);
#pragma unroll
          for (int bj = 0; bj < 2; ++bj) {
            const int pos = bj == 0 ? (s >> 6) : (s & 63);
            const f32x4 t0 = *(const f32x4*)(rope + (pos * 16 + 4 * fq) * 2), t1 = *(const f32x4*)(rope + (pos * 16 + 4 * fq) * 2 + 4);
            const f32x4 cs = {t0[0], t0[2], t1[0], t1[2]}, sn = {t0[1], t0[3], t1[1], t1[3]};
            const f32x4 x1 = v[bj][0], x2 = v[bj][1];
            v[bj][0] = x1 * cs - x2 * sn; v[bj][1] = x2 * cs + x1 * sn;
          }
        }
#pragma unroll
        for (int bj = 0; bj < 2; ++bj)
#pragma unroll
          for (int n = 0; n < 2; ++n) *(u32x2*)(dst + (size_t)row * pitch + dcol + 32 * bj + 16 * n + 4 * fq) = pack4(v[bj][n] * scale);
        asm volatile("" ::: "memory");
      }
  }

  DI void operator()(const pg8::f32x4 (&acc)[2][2][4][2], const pg8::Unit& u, int wr, int wc, int fr, int fq) const {
    asm volatile("" : "+v"(fr), "+v"(fq));
    const int pn = u.pn + pn_off;
    const int row0 = u.pm * 256 + wr * 64 + fr;
    const bool lat = u.pm < (MLAT / 256);
    if (pn <= 1) head_tile(acc, row0, fq, true, qn, Qa, 512, 64 * (4 * pn + wc), QSCALE, lat);
    else if (pn == 2) { if (wc < 2) head_tile(acc, row0, fq, true, kn, Ka, 128, 64 * wc, 1.0f, lat); else head_tile(acc, row0, fq, false, kn, Va, 128, 64 * (wc - 2), 1.0f, false); }
    else if (pn <= 10) {
      const int ch = 64 * (pn - 3) + 16 * wc + 4 * fq;
#pragma unroll
      for (int ai = 0; ai < 2; ++ai)
#pragma unroll
        for (int m = 0; m < 4; ++m) {
          const int row = row0 + 128 * ai + 16 * m;
          const f32x4 bh = acc[ai][0][m][0], bb = acc[ai][0][m][1], bc = acc[ai][1][m][0], bg = acc[ai][1][m][1];
          f32x4 pre;
#pragma unroll
          for (int e = 0; e < 4; ++e) pre[e] = siluf_(bg[e]) * bb[e];
          *(u32x2*)(U + (size_t)row * 512 + ch) = pack4(bc * bh);
          *(u32x2*)(SGP + (size_t)row * 1536 + 512 + ch) = pack4(pre);
        }
    }
    else if (pn <= 12) head_tile(acc, row0, fq, false, qn, Qc, 512, 256 * (pn - 11) + 64 * wc, QSCALE, lat);
    else if (pn <= 14) head_tile(acc, row0, fq, false, qn, Kc, 512, 256 * (pn - 13) + 64 * wc, 1.0f, lat);
    else if (pn >= 21) {
      unsigned char* dst = (unsigned char*)G + (size_t)((pn - 21) >> 2) * ((size_t)MTOT * 1024) + 256 * ((pn - 21) & 3) + 32 * wc + 8 * fq;
#pragma unroll
      for (int ai = 0; ai < 2; ++ai)
#pragma unroll
        for (int m = 0; m < 4; ++m) {
          const int row = row0 + 128 * ai + 16 * m;
#pragma unroll
          for (int bj = 0; bj < 2; ++bj) {
            u32x2 wv;
#pragma unroll
            for (int n = 0; n < 2; ++n) {
              const f32x4 v = acc[ai][bj][m][n]; unsigned wq = 0u;
#pragma unroll
              for (int e = 0; e < 4; ++e) { const float q = fmaxf(__builtin_fmaf(255.0f, frcp(1.0f + fexp2(-1.4426950408889634f * v[e])), 0.5f), 1.0f); wq |= ((unsigned)q) << (8 * e); }
              wv[n] = wq;
            }
            *(u32x2*)(dst + (size_t)row * 1024 + 128 * bj) = wv;
          }
        }
    }
    else {
      bf16_t* dst; int pitch, dcol, act;
      if (pn <= 16) { dst = Vc; pitch = 512; dcol = 256 * (pn - 15); act = 0; }
      else if (pn <= 20) { dst = SGP; pitch = 1536; dcol = (pn < 19 ? 0 : 1024) + 256 * ((pn - 17) & 1); act = 1; }
      else { dst = G + (size_t)((pn - 21) >> 2) * ((size_t)MTOT * 1024); pitch = 1024; dcol = 256 * ((pn - 21) & 3); act = 2; }
#pragma unroll
      for (int ai = 0; ai < 2; ++ai)
#pragma unroll
        for (int m = 0; m < 4; ++m) {
          const int row = row0 + 128 * ai + 16 * m;
#pragma unroll
          for (int bj = 0; bj < 2; ++bj)
#pragma unroll
            for (int n = 0; n < 2; ++n) {
              f32x4 v = acc[ai][bj][m][n];
              if (act == 1) {
#pragma unroll
                for (int e = 0; e < 4; ++e) v[e] = siluf_(v[e]);
              } else if (act == 2) {
#pragma unroll
                for (int e = 0; e < 4; ++e) v[e] = sigmoidf_(v[e]);
              }
              *(u32x2*)(dst + (size_t)row * pitch + dcol + 128 * bj + 32 * wc + 16 * n + 4 * fq) = pack4(v);
            }
        }
    }
  }
};

template <bool SUB3>
struct ListOrder {
  int n; unsigned packed;
  DI void clear() { n = 0; packed = 0u; }
  DI void set0(int pm, int pn) { packed = (unsigned)((pm << 2) | pn); n = 1; }
  DI void set1(int pm, int pn) { packed |= (unsigned)((pm << 2) | pn) << 10; n = 2; }
  DI bool next(int i, pg8::Unit& u) const {
    const int ui = SUB3 ? i / 3 : i; if (ui >= n) return false;
    const int v = (int)((packed >> (10 * ui)) & 1023u);
    u.pm = v >> 2; u.pn = v & 3; u.br = SUB3 ? i % 3 : 0; u.kb = u.br * 1024; return true;
  }
  DI void a_ready(const pg8::Unit&) const {}
  DI void done(const pg8::Unit&) const {}
};
struct EpiGM {
  static constexpr bool PERM = true, AFTER_DRAIN = false;
  const unsigned char* G; bf16_t* MG;
  DI void operator()(const pg8::f32x4 (&acc)[2][2][4][2], const pg8::Unit& u, int wr, int wc, int fr, int fq) const {}
  DI void sub(pg8::f32x4 (&acc)[2][2][4][2], const pg8::Unit& u, int wr, int wc, int fr, int fq) const {
    asm volatile("" : "+v"(fr), "+v"(fq));
    const int br = u.br;
    const unsigned char* gn = G + (size_t)br * ((size_t)MTOT * 1024);
    const unsigned char* gd = G + (size_t)(br < 2 ? br + 1 : 2) * ((size_t)MTOT * 1024);
    const int row0 = u.pm * 256 + wr * 64 + fr, col0 = u.pn * 256 + 32 * wc + 8 * fq;
#pragma unroll
    for (int ai = 0; ai < 2; ++ai) {
      u32x2 ga[4][2], gb[4][2];
#pragma unroll
      for (int m = 0; m < 4; ++m)
#pragma unroll
        for (int bj = 0; bj < 2; ++bj) {
          const size_t ro = (size_t)(row0 + 128 * ai + 16 * m) * 1024 + col0 + 128 * bj;
          ga[m][bj] = *(const u32x2*)(gn + ro); gb[m][bj] = (br < 2) ? *(const u32x2*)(gd + ro) : ga[m][bj];
        }
#pragma unroll
      for (int m = 0; m < 4; ++m) {
#pragma unroll
        for (int bj = 0; bj < 2; ++bj) {
          const size_t ro = (size_t)(row0 + 128 * ai + 16 * m) * 1024 + col0 + 128 * bj;
          f32x4 a[2], r[2];
#pragma unroll
          for (int n = 0; n < 2; ++n)
#pragma unroll
            for (int e = 0; e < 4; ++e) {
              a[n][e] = (float)((ga[m][bj][n] >> (8 * e)) & 0xffu);
              const float bq = (float)((gb[m][bj][n] >> (8 * e)) & 0xffu);
              r[n][e] = (br == 2) ? 0.0f : a[n][e] * frcp(bq);
            }
          if (br == 2) { const u32x2 s0 = pack4(acc[ai][bj][m][0] * a[0] * (1.0f / 255.0f)), s1 = pack4(acc[ai][bj][m][1] * a[1] * (1.0f / 255.0f)); *(u32x4*)(MG + ro) = (u32x4){s0[0], s0[1], s1[0], s1[1]}; }
          acc[ai][bj][m][0] = acc[ai][bj][m][0] * r[0]; acc[ai][bj][m][1] = acc[ai][bj][m][1] * r[1];
        }
        asm volatile("" : "+v"(acc[ai][0][m][0]), "+v"(acc[ai][0][m][1]), "+v"(acc[ai][1][m][0]), "+v"(acc[ai][1][m][1]) :: "memory");
      }
    }
  }
};

struct OrderGI {
  pg8::StaticOrder base; int extra;
  DI bool next(int i, pg8::Unit& u) const {
    if (base.next(i, u)) return true;
    const long L = (long)i * base.G + base.c; const int k = (int)(L - base.nwg);
    if (k < 0 || k >= extra) return false;
    const int r = k % 5;
    u.pm = (MLAT / 256) + k / 5; u.pn = r == 0 ? 2 : 12 + r; u.kb = 0; u.br = 0; return true;
  }
  DI void a_ready(const pg8::Unit&) const {}
  DI void done(const pg8::Unit&) const {}
};
DI int late_base(int x) { return 16 * (x + 1) + (x >= 4 ? 8 : 0); }
struct EpiGO {
  static constexpr bool PERM = true, AFTER_DRAIN = false;
  const float *src_lat, *src_ctx; float *dst_lat, *dst_ctx; const float* mod;
  DI void operator()(const pg8::f32x4 (&acc)[2][2][4][2], const pg8::Unit& u, int wr, int wc, int fr, int fq) const {
    asm volatile("" : "+v"(fr), "+v"(fq));
    const int row0 = u.pm * 256 + wr * 64 + fr, col0 = u.pn * 256 + 32 * wc + 8 * fq;
    const bool lat = u.pm < (MLAT / 256);
    const int b = lat ? (u.pm >> 3) : 16;
    const float* gate = mod + b * 3072 + 2048 + col0;
    f32x4 gv[2][2];
#pragma unroll
    for (int bj = 0; bj < 2; ++bj)
#pragma unroll
      for (int n = 0; n < 2; ++n) gv[bj][n] = *(const f32x4*)(gate + 128 * bj + 4 * n);
    const float* src = lat ? src_lat : src_ctx - (size_t)MLAT * 1024;
    float* dst = lat ? dst_lat : dst_ctx - (size_t)MLAT * 1024;
#pragma unroll
    for (int ai = 0; ai < 2; ++ai) {
      f32x4 xo[4][2][2];
#pragma unroll
      for (int m = 0; m < 4; ++m)
#pragma unroll
        for (int bj = 0; bj < 2; ++bj)
#pragma unroll
          for (int n = 0; n < 2; ++n) xo[m][bj][n] = *(const f32x4*)(src + (size_t)(row0 + 128 * ai + 16 * m) * 1024 + col0 + 128 * bj + 4 * n);
#pragma unroll
      for (int m = 0; m < 4; ++m)
#pragma unroll
        for (int bj = 0; bj < 2; ++bj)
#pragma unroll
          for (int n = 0; n < 2; ++n) *(f32x4*)(dst + (size_t)(row0 + 128 * ai + 16 * m) * 1024 + col0 + 128 * bj + 4 * n) = xo[m][bj][n] + gv[bj][n] * acc[ai][bj][m][n];
      asm volatile("" ::: "memory");
    }
  }
};

template <bool PERMUTE>
DI void p0_item(const float* W, int N, bf16_t* WT, int ldo, int ocol, int k0, int p0, LAS float* scr, int lane) {
  const int src = PERMUTE ? logical_col(p0 + (lane & 31)) : p0 + (lane & 31);
#pragma unroll 16
  for (int i = 0; i < 32; ++i) { const int kk = 2 * i + (lane >> 5); scr[kk * 33 + (lane & 31)] = W[(size_t)(k0 + kk) * N + src]; }
  asm volatile("s_waitcnt lgkmcnt(0)" ::: "memory");
  const int c = lane & 7;
#pragma unroll
  for (int j = 0; j < 4; ++j) {
    const int n = (lane >> 3) + 8 * j; const LAS float* s = scr + (8 * c) * 33 + n;
    u32x4 o; o.x = pk2(s[0 * 33], s[1 * 33]); o.y = pk2(s[2 * 33], s[3 * 33]); o.z = pk2(s[4 * 33], s[5 * 33]); o.w = pk2(s[6 * 33], s[7 * 33]);
    *(u32x4*)(WT + (size_t)(p0 + n) * ldo + ocol + k0 + 8 * c) = o;
  }
  asm volatile("s_waitcnt lgkmcnt(0)" ::: "memory");
}

DI void sincos_red(float ang, float& s, float& c) {
  const double a = (double)ang;
  const double q = __builtin_rint(a * 0.63661977236758134308);
  const float r = (float)(a - q * 1.57079632679489661923);
  const float r2 = r * r;
  const float sp = r + r * r2 * (-1.6666654611e-1f + r2 * (8.3321608736e-3f + r2 * (-1.9515295891e-4f)));
  const float cp = 1.0f + r2 * (-0.5f + r2 * (4.166664568298827e-2f + r2 * (-1.388731625493765e-3f + r2 * 2.443315711809948e-5f)));
  const int qi = ((int)q) & 3;
  s = (qi == 0) ? sp : (qi == 1) ? cp : (qi == 2) ? -sp : -cp;
  c = (qi == 0) ? cp : (qi == 1) ? -sp : (qi == 2) ? -cp : sp;
}

DI void phase0(const Params& P, LAS unsigned char* lds) {
  const int tid = opaque_tid(), lane = tid & 63, w = tid >> 6, G = gridDim.x, bid = blockIdx.x;
  float* MOD = (float*)(P.ws + WS_MOD);
  for (int item = bid; item < 192; item += G) {
    LAS float* sc = (LAS float*)(lds + 67584);
    for (int i = tid; i < 17 * 1024; i += NTHREADS) { const float v = i < 16384 ? P.c[i] : P.c_ctx[i - 16384]; sc[i] = v / (1.0f + __expf(-v)); }
    __syncthreads();
    const int l = item / 48, n0 = (item % 48) * 64;
    const float* W = P.w_mod + (size_t)l * 1024 * 3072 + n0 + lane;
    float acc[17];
#pragma unroll
    for (int b = 0; b < 17; ++b) acc[b] = 0.f;
    const int kb = w * 128;
#pragma unroll 4
    for (int k = kb; k < kb + 128; k += 4) {
      const float w0 = W[(size_t)k * 3072], w1 = W[(size_t)(k + 1) * 3072], w2 = W[(size_t)(k + 2) * 3072], w3 = W[(size_t)(k + 3) * 3072];
#pragma unroll
      for (int b = 0; b < 17; ++b) { const f32x4 s = *(const LAS f32x4*)(sc + b * 1024 + k); acc[b] += (s[0] * w0 + s[1] * w1) + (s[2] * w2 + s[3] * w3); }
    }
    LAS float* red = (LAS float*)lds;
#pragma unroll
    for (int b = 0; b < 17; ++b) red[(w * 17 + b) * 64 + lane] = acc[b];
    __syncthreads();
    for (int i = tid; i < 17 * 64; i += NTHREADS) {
      const int b = i >> 6, ln = i & 63; float s = 0.f;
#pragma unroll
      for (int ww = 0; ww < 8; ++ww) s += red[(ww * 17 + b) * 64 + ln];
      MOD[(size_t)(l * 17 + b) * 3072 + n0 + ln] = s + P.b_mod[l * 3072 + n0 + ln];
    }
    __syncthreads();
  }
  if (bid == G - 1) {
    float* rope = (float*)(P.ws + WS_ROPE);
    for (int i = tid; i < 1024; i += NTHREADS) {
      const int pos = i >> 4, f = i & 15;
      const float inv = exp2f(-(float)f * (13.287712379549449f / 16.0f));
      float s, c; sincos_red((float)pos * inv, s, c);
      rope[2 * i] = c; rope[2 * i + 1] = s;
    }
    if (w < DEPTH) {
      float a = P.lq1[w * 64 + lane] * P.lk1[w * 64 + lane], b = P.lq2[w * 64 + lane] * P.lk2[w * 64 + lane];
      a = wave_sum(a); b = wave_sum(b);
      if (lane == 0) ((float*)(P.ws + WS_LAM))[w] = expf(a) - expf(b) + P.lam_init[w];
    }
  }
  LAS float* scr = (LAS float*)(lds + w * 8448);
  const int gw = bid * 8 + w, NGW = G * 8;
  constexpr int PER_L = 4224 + 768 + 512;
  for (int it = gw; it < DEPTH * PER_L; it += NGW) {
    const int l = it / PER_L; int r = it % PER_L;
    if (r < 4224) { p0_item<true>(P.w_in + (size_t)l * 1024 * PROJ, PROJ, (bf16_t*)(P.ws + WS_WIN) + (size_t)l * PROJ * 1024, 1024, 0, 64 * (r / 264), 32 * (r % 264), scr, lane); continue; }
    r -= 4224;
    if (r < 768) { const int br = r >> 8, rr = r & 255; const float* W = (br == 0 ? P.wa : br == 1 ? P.wb : P.wc) + (size_t)l * 512 * 1024;
      p0_item<false>(W, 1024, (bf16_t*)(P.ws + WS_WM) + (size_t)l * 1024 * 1536, 1536, 512 * br, 64 * (rr >> 5), 32 * (rr & 31), scr, lane); continue; }
    r -= 768;
    p0_item<false>(P.wo + (size_t)l * 1024 * 1024, 1024, (bf16_t*)(P.ws + WS_WO) + (size_t)l * 1024 * 1024, 1024, 0, 64 * (r >> 5), 32 * (r & 31), scr, lane);
  }
}

DI void norm_phase(const Params& P, int l) {
  const int tid = opaque_tid(), lane = tid & 63, w = tid >> 6;
  const int gw = blockIdx.x * 8 + w, NGW = gridDim.x * 8;
  const float* MOD = (const float*)(P.ws + WS_MOD) + (size_t)l * 17 * 3072;
  bf16_t* H = (bf16_t*)(P.ws + WS_H);
  constexpr int NR = 4, QROWS = MTOT / NR;
  for (int rp = gw; rp < QROWS; rp += NGW) {
    f32x4 v[NR][4]; float ss[NR];
#pragma unroll
    for (int q = 0; q < NR; ++q) {
      const int row = rp + q * QROWS;
      const bool lat = row < MLAT;
      const float* src = lat ? ((l == 0 ? P.x : (const float*)P.out) + (size_t)row * 1024) : ((l == 0 ? P.ctx : (const float*)(P.ws + WS_XC)) + (size_t)(row - MLAT) * 1024);
#pragma unroll
      for (int j = 0; j < 4; ++j) v[q][j] = *(const f32x4*)(src + 256 * j + 4 * lane);
    }
#pragma unroll
    for (int q = 0; q < NR; ++q) {
      ss[q] = 0.f;
#pragma unroll
      for (int j = 0; j < 4; ++j) ss[q] += (v[q][j][0] * v[q][j][0] + v[q][j][1] * v[q][j][1]) + (v[q][j][2] * v[q][j][2] + v[q][j][3] * v[q][j][3]);
      ss[q] = wave_sum(ss[q]);
    }
#pragma unroll
    for (int q = 0; q < NR; ++q) {
      const int row = rp + q * QROWS;
      const int b = row < MLAT ? (row >> 11) : 16;
      const float rs = 1.0f / sqrtf(ss[q] * (1.0f / 1024.0f) + EPS);
#pragma unroll
      for (int j = 0; j < 4; ++j) {
        const f32x4 sh = *(const f32x4*)(MOD + b * 3072 + 256 * j + 4 * lane), sc = *(const f32x4*)(MOD + b * 3072 + 1024 + 256 * j + 4 * lane);
        const f32x4 h = v[q][j] * rs * (sc + 1.0f) + sh;
        *(u32x2*)(H + (size_t)row * 1024 + 256 * j + 4 * lane) = pack4(h);
      }
    }
  }
}

DI void final_phase(const Params& P) {
  const int tid = opaque_tid(), lane = tid & 63, w = tid >> 6;
  const int gw = blockIdx.x * 8 + w, NGW = gridDim.x * 8;
  for (int row = gw; row < MLAT; row += NGW) {
    float* src = P.out + (size_t)row * 1024;
    f32x4 v[4]; float ss = 0.f;
#pragma unroll
    for (int j = 0; j < 4; ++j) { v[j] = *(const f32x4*)(src + 256 * j + 4 * lane); ss += (v[j][0] * v[j][0] + v[j][1] * v[j][1]) + (v[j][2] * v[j][2] + v[j][3] * v[j][3]); }
    ss = wave_sum(ss);
    const float rs = 1.0f / sqrtf(ss * (1.0f / 1024.0f) + EPS);
#pragma unroll
    for (int j = 0; j < 4; ++j) { const f32x4 g = *(const f32x4*)(P.fnorm + 256 * j + 4 * lane); f32x4 ov = v[j] * rs * g;
      *(f32x4*)(src + 256 * j + 4 * lane) = ov; }
  }
}

#define MFMA32(a, b, c) __builtin_amdgcn_mfma_f32_32x32x16_bf16((a), (b), (c), 0, 0, 0)
DI int crow(int reg, int h) { return (reg & 3) + 8 * (reg >> 2) + 4 * h; }
DI s16x4 vtr(const LAS unsigned char* p) { return __builtin_bit_cast(s16x4, __builtin_amdgcn_ds_read_tr16_b64_v4i16((LAS s16x4*)p)); }

constexpr int KT_B = 8192;
constexpr int XCH_OFF = 0;
DI void glds16(const void* gsrc, unsigned lds_dst) { unsigned keep;
  asm volatile("s_mov_b32 %0, m0\n\ts_mov_b32 m0, %2\n\ts_nop 0\n\tglobal_load_lds_dwordx4 %1, off\n\ts_mov_b32 m0, %0" : "=&s"(keep) : "v"(gsrc), "s"(lds_dst) : "memory"); }
DI float xhalf_max(float m) { const auto rr = __builtin_amdgcn_permlane32_swap(__float_as_uint(m), __float_as_uint(m), false, false); return fmaxf(__uint_as_float(rr[0]), __uint_as_float(rr[1])); }
DI float xhalf_sum(float m) { const auto rr = __builtin_amdgcn_permlane32_swap(__float_as_uint(m), __float_as_uint(m), false, false); return __uint_as_float(rr[0]) + __uint_as_float(rr[1]); }
#define AT_WAITBAR(N) asm volatile("s_waitcnt vmcnt(" #N ") lgkmcnt(0)\n\ts_barrier" ::: "memory")

template <int MODE>
DI void attn_unit(const Params& P, LAS unsigned char* lds, int l, int b, int hg, int qt, bool ctxunit) {
  constexpr int DV = MODE ? 128 : 64, NK = MODE ? 2 : 1, NVB = MODE ? 2 : 1, VROW = DV * 2, VT_B = 64 * VROW, NDB = DV / 32;
  constexpr int KSLOT = NK * KT_B, VRING = 3 * KSLOT;
  constexpr float THR = 6.0f;
  const int tid = opaque_tid(), lane = tid & 63, r = lane & 31, h = lane >> 5, w = __builtin_amdgcn_readfirstlane(tid >> 6);
  const bf16_t* Kg = (const bf16_t*)(P.ws + (MODE ? WS_KC : WS_KA));
  const bf16_t* Vg = (const bf16_t*)(P.ws + (MODE ? WS_VC : WS_VA));
  const bf16_t* Qg = (const bf16_t*)(P.ws + (MODE ? WS_QC : WS_QA));
  bf16_t* SGP = (bf16_t*)(P.ws + WS_SGP);
  constexpr int KP = MODE ? 512 : 128;
  const int kcol = MODE ? 128 * hg : 64 * hg;
  const int NT = ctxunit ? 4 : 36;
  const int qsub = MODE ? (w & 3) : (w >> 2), kidx = MODE ? (w >> 2) : 0;
  const int qrow = (ctxunit ? MLAT + b * CTXL : b * SEQ) + qt * (MODE ? 128 : 64) + 32 * qsub + r;
  const int qcol = MODE ? 128 * hg + 64 * kidx : 64 * (4 * hg + (w & 3));
  const unsigned lds0 = (unsigned)(uintptr_t)lds;
  const int krow_ = 8 * w + (lane >> 3);
  const int kgo = krow_ * KP + kcol + 8 * ((lane & 7) ^ ((krow_ >> 1) & 7));
  const int vrow_ = MODE ? 4 * w + (lane >> 4) : 8 * w + (lane >> 3);
  const int vgo = MODE ? vrow_ * KP + kcol + 8 * ((lane & 15) ^ ((vrow_ & 3) << 2)) : vrow_ * KP + kcol + 8 * ((lane & 7) ^ (((vrow_ >> 1) & 1) << 2));
#define TILE_ROW(j) (((ctxunit) || (j) < 4) ? MLAT + b * CTXL + 64 * (j) : b * SEQ + 64 * ((j) - 4))
#define DMA_K(t) do { const bf16_t* g_ = Kg + (size_t)TILE_ROW(t) * KP + kgo; const unsigned d_ = lds0 + ((t) % 3) * KSLOT + w * 1024; \
    glds16(g_, (unsigned)__builtin_amdgcn_readfirstlane(d_)); if (MODE) glds16(g_ + 64, (unsigned)__builtin_amdgcn_readfirstlane(d_ + KT_B)); } while (0)
#define DMA_V(t) do { const bf16_t* g_ = Vg + (size_t)TILE_ROW(t) * KP + vgo; const unsigned d_ = lds0 + VRING + ((t) % 3) * VT_B + w * 1024; \
    glds16(g_, (unsigned)__builtin_amdgcn_readfirstlane(d_)); if (MODE) glds16(g_ + 32 * KP, (unsigned)__builtin_amdgcn_readfirstlane(d_ + 8192)); } while (0)
  if (w >= 4) __builtin_amdgcn_s_setprio(1);
  DMA_K(0); DMA_V(0); DMA_K(1); DMA_V(1); if (MODE == 0) DMA_K(2);
  bf16x8 qf[4];
#pragma unroll
  for (int s = 0; s < 4; ++s) qf[s] = *(const bf16x8*)(Qg + (size_t)qrow * 512 + qcol + 16 * s + 8 * h);
  f32x16 o[NDB], negm;
#pragma unroll
  for (int d = 0; d < NDB; ++d)
#pragma unroll
    for (int i = 0; i < 16; ++i) o[d][i] = 0.f;
#pragma unroll
  for (int i = 0; i < 16; ++i) negm[i] = 0.f;
  float mref = 0.f, lrun = 0.f;
  const int i16 = lane & 15, tq = i16 >> 2, tp = i16 & 3;
  int kro[4], vo[NDB];
#pragma unroll
  for (int s = 0; s < 4; ++s) kro[s] = kidx * KT_B + r * 128 + 16 * ((2 * s + h) ^ ((r >> 1) & 7));
  const int vsw = MODE ? tq : ((tq >> 1) & 1);
#pragma unroll
  for (int d = 0; d < NDB; ++d) vo[d] = VRING + (4 * h + tq) * VROW + 64 * (d ^ vsw) + 32 * ((lane >> 4) & 1) + 8 * tp;
  AT_WAITBAR(0);
#define QK(P0, P1, t) do { const LAS unsigned char* Kt_ = lds + ((t) % 3) * KSLOT; \
    _Pragma("unroll") for (int s = 0; s < 4; ++s) { \
      const bf16x8 k0_ = *(const LAS bf16x8*)(Kt_ + kro[s]), k1_ = *(const LAS bf16x8*)(Kt_ + kro[s] + 32 * 128); \
      if (s == 0) { P0 = MFMA32(k0_, qf[0], negm); P1 = MFMA32(k1_, qf[0], negm); } else { P0 = MFMA32(k0_, qf[s], P0); P1 = MFMA32(k1_, qf[s], P1); } } } while (0)
#define VTR(dst, addr, OFF) asm volatile("ds_read_b64_tr_b16 %0, %1 offset:%2" : "=v"(dst) : "v"(addr), "i"(OFF) : "memory")
#define VFRAG(lo_, hi_) __builtin_shufflevector(lo_, hi_, 0, 1, 2, 3, 4, 5, 6, 7)
#define SOFTMAX(C0, C1, N0, N1, j, HASN) \
      \
    float mx_ = 0.f; \
    if (((j) & 7) == 0) { mx_ = fmaxf(C0[0], C1[0]); \
      _Pragma("unroll") for (int i = 1; i < 16; ++i) mx_ = fmaxf(fmaxf(mx_, C0[i]), C1[i]); \
      mx_ = xhalf_max(mx_); } \
    if ((j) == 0 || (((j) & 7) == 0 && __any(mx_ > THR))) { \
      const float dl_ = ((j) == 0) ? mx_ : fmaxf(mx_, 0.f); \
      _Pragma("unroll") for (int i = 0; i < 16; ++i) { C0[i] -= dl_; C1[i] -= dl_; } \
      if (HASN) { if ((j) + 1 < NT) { _Pragma("unroll") for (int i = 0; i < 16; ++i) { N0[i] -= dl_; N1[i] -= dl_; } } } \
      mref += dl_; \
      _Pragma("unroll") for (int i = 0; i < 16; ++i) negm[i] = -mref; \
      const float al_ = fexp2(-dl_); lrun *= al_; \
      _Pragma("unroll") for (int d = 0; d < NDB; ++d) _Pragma("unroll") for (int i = 0; i < 16; ++i) o[d][i] *= al_; \
    } \
    C0[0] = fexp2(C0[0]); C1[0] = fexp2(C1[0]); float sa_ = C0[0], sb_ = C1[0]; \
    _Pragma("unroll") for (int i = 1; i < 16; ++i) { C0[i] = fexp2(C0[i]); C1[i] = fexp2(C1[i]); sa_ += C0[i]; asm("" : "+v"(sa_)); sb_ += C1[i]; } \
    lrun += sa_ + sb_; \
    bf16x8 pb_[4]; \
    { u32x4 t_; \
      t_ = (u32x4){pk2(C0[0], C0[1]), pk2(C0[2], C0[3]), pk2(C0[4], C0[5]), pk2(C0[6], C0[7])}; pb_[0] = __builtin_bit_cast(bf16x8, t_); \
      t_ = (u32x4){pk2(C0[8], C0[9]), pk2(C0[10], C0[11]), pk2(C0[12], C0[13]), pk2(C0[14], C0[15])}; pb_[1] = __builtin_bit_cast(bf16x8, t_); \
      t_ = (u32x4){pk2(C1[0], C1[1]), pk2(C1[2], C1[3]), pk2(C1[4], C1[5]), pk2(C1[6], C1[7])}; pb_[2] = __builtin_bit_cast(bf16x8, t_); \
      t_ = (u32x4){pk2(C1[8], C1[9]), pk2(C1[10], C1[11]), pk2(C1[12], C1[13]), pk2(C1[14], C1[15])}; pb_[3] = __builtin_bit_cast(bf16x8, t_); }
#define STEP_A(C0, C1, N0, N1, j) do { \
    if ((j) + 3 < NT) DMA_K((j) + 3); \
    if ((j) + 2 < NT) DMA_V((j) + 2); \
    if ((j) + 1 < NT) { QK(N0, N1, (j) + 1); } \
    s16x4 vl_[4][2], vh_[4][2]; \
    { const unsigned va0_ = lds0 + ((j) % 3) * VT_B + vo[0], va1_ = lds0 + ((j) % 3) * VT_B + vo[1]; \
      VTR(vl_[0][0], va0_, 0 * VROW); VTR(vh_[0][0], va0_, 8 * VROW); VTR(vl_[0][1], va1_, 0 * VROW); VTR(vh_[0][1], va1_, 8 * VROW); \
      VTR(vl_[1][0], va0_, 16 * VROW); VTR(vh_[1][0], va0_, 24 * VROW); VTR(vl_[1][1], va1_, 16 * VROW); VTR(vh_[1][1], va1_, 24 * VROW); \
      VTR(vl_[2][0], va0_, 32 * VROW); VTR(vh_[2][0], va0_, 40 * VROW); VTR(vl_[2][1], va1_, 32 * VROW); VTR(vh_[2][1], va1_, 40 * VROW); \
      VTR(vl_[3][0], va0_, 48 * VROW); VTR(vh_[3][0], va0_, 56 * VROW); VTR(vl_[3][1], va1_, 48 * VROW); VTR(vh_[3][1], va1_, 56 * VROW); } \
    SOFTMAX(C0, C1, N0, N1, j, true) \
    asm volatile("s_waitcnt lgkmcnt(0)" : "+v"(vl_[0][0]), "+v"(vh_[0][0]), "+v"(vl_[0][1]), "+v"(vh_[0][1]), "+v"(vl_[1][0]), "+v"(vh_[1][0]), "+v"(vl_[1][1]), "+v"(vh_[1][1]), \
                 "+v"(vl_[2][0]), "+v"(vh_[2][0]), "+v"(vl_[2][1]), "+v"(vh_[2][1]), "+v"(vl_[3][0]), "+v"(vh_[3][0]), "+v"(vl_[3][1]), "+v"(vh_[3][1]) :: "memory"); \
    _Pragma("unroll") for (int s = 0; s < 4; ++s) _Pragma("unroll") for (int d = 0; d < 2; ++d) o[d] = MFMA32(VFRAG(vl_[s][d], vh_[s][d]), pb_[s], o[d]); \
    if ((j) + 3 < NT) { AT_WAITBAR(2); } else AT_WAITBAR(0); \
  } while (0)
#define VGRP(vl, vh, s, va) do { VTR(vl[0], va[0], (16 * (s)) * VROW); VTR(vh[0], va[0], (16 * (s) + 8) * VROW); VTR(vl[1], va[1], (16 * (s)) * VROW); VTR(vh[1], va[1], (16 * (s) + 8) * VROW); \
    VTR(vl[2], va[2], (16 * (s)) * VROW); VTR(vh[2], va[2], (16 * (s) + 8) * VROW); VTR(vl[3], va[3], (16 * (s)) * VROW); VTR(vh[3], va[3], (16 * (s) + 8) * VROW); } while (0)
#define VWAIT(N, vl, vh) asm volatile("s_waitcnt lgkmcnt(" #N ")" : "+v"(vl[0]), "+v"(vh[0]), "+v"(vl[1]), "+v"(vh[1]), "+v"(vl[2]), "+v"(vh[2]), "+v"(vl[3]), "+v"(vh[3]) :: "memory")
#define STEP_C(C0, C1, j) do { \
    if ((j) + 2 < NT) { DMA_K((j) + 2); DMA_V((j) + 2); } \
    QK(C0, C1, (j)); \
    s16x4 xl_[4], xh_[4], yl_[4], yh_[4]; unsigned va_[4]; \
    _Pragma("unroll") for (int d = 0; d < 4; ++d) va_[d] = lds0 + ((j) % 3) * VT_B + vo[d]; \
    VGRP(xl_, xh_, 0, va_); VGRP(yl_, yh_, 1, va_); \
    SOFTMAX(C0, C1, C0, C1, j, false) \
    VWAIT(8, xl_, xh_); \
    _Pragma("unroll") for (int d = 0; d < 4; ++d) o[d] = MFMA32(VFRAG(xl_[d], xh_[d]), pb_[0], o[d]); \
    VGRP(xl_, xh_, 2, va_); \
    VWAIT(8, yl_, yh_); \
    _Pragma("unroll") for (int d = 0; d < 4; ++d) o[d] = MFMA32(VFRAG(yl_[d], yh_[d]), pb_[1], o[d]); \
    VGRP(yl_, yh_, 3, va_); \
    VWAIT(8, xl_, xh_); \
    _Pragma("unroll") for (int d = 0; d < 4; ++d) o[d] = MFMA32(VFRAG(xl_[d], xh_[d]), pb_[2], o[d]); \
    VWAIT(0, yl_, yh_); \
    _Pragma("unroll") for (int d = 0; d < 4; ++d) o[d] = MFMA32(VFRAG(yl_[d], yh_[d]), pb_[3], o[d]); \
    if ((j) + 2 < NT) { AT_WAITBAR(4); } else AT_WAITBAR(0); \
  } while (0)
  f32x16 pA0, pA1;
  if (MODE == 0) {
    f32x16 pB0, pB1;
    QK(pA0, pA1, 0);
    AT_WAITBAR(0);
    for (int j = 0; j < NT; j += 2) {
      STEP_A(pA0, pA1, pB0, pB1, j);
      STEP_A(pB0, pB1, pA0, pA1, j + 1);
    }
  } else {
    for (int j = 0; j < NT; ++j) STEP_C(pA0, pA1, j);
  }
#undef STEP_A
#undef STEP_C
#undef SOFTMAX
#undef VGRP
#undef VWAIT
#undef VTR
#undef VFRAG
#undef QK
#undef DMA_K
#undef DMA_V
#undef TILE_ROW
  __builtin_amdgcn_s_setprio(0);
  const float lt = xhalf_sum(lrun);
  const float inv = 1.0f / lt;
  if (MODE == 0) {
    bf16_t* zrow = SGP + (size_t)qrow * 1536 + 64 * (4 * hg + (w & 3));
#pragma unroll
    for (int d = 0; d < NDB; ++d)
#pragma unroll
      for (int gq = 0; gq < 4; ++gq) {
        bf16_t* p = zrow + 32 * d + 8 * gq + 4 * h;
        const f32x4 g = unpack4(*(const u32x2*)p);
        const f32x4 v = {o[d][4 * gq] * inv * g[0], o[d][4 * gq + 1] * inv * g[1], o[d][4 * gq + 2] * inv * g[2], o[d][4 * gq + 3] * inv * g[3]};
        *(u32x2*)p = pack4(v);
      }
  } else {
    LAS float* xch = (LAS float*)(lds + XCH_OFF) + (size_t)qsub * (NDB * 16 * 64) + lane;
    const float lam = ((const float*)(P.ws + WS_LAM))[l];
    if (kidx == 1) {
      const float f = inv * lam;
#pragma unroll
      for (int d = 0; d < NDB; ++d)
#pragma unroll
        for (int i = 0; i < 16; ++i) xch[(d * 16 + i) * 64] = o[d][i] * f;
    }
    __syncthreads();
    if (kidx == 0) {
      float ss = 0.f;
#pragma unroll
      for (int d = 0; d < NDB; ++d)
#pragma unroll
        for (int i = 0; i < 16; ++i) { const float y = o[d][i] * inv - xch[(d * 16 + i) * 64]; o[d][i] = y; ss += y * y; }
      ss += __shfl_xor(ss, 32);
      const float rs = (1.0f / sqrtf(ss * (1.0f / 128.0f) + EPS)) * (1.0f - P.lam_init[l]);
      const float* sub = P.subln + l * 128;
      bf16_t* zrow = SGP + (size_t)qrow * 1536 + 1024 + 128 * hg;
#pragma unroll
      for (int d = 0; d < NDB; ++d)
#pragma unroll
        for (int gq = 0; gq < 4; ++gq) {
          const int dv = 32 * d + 8 * gq + 4 * h;
          const f32x4 g = unpack4(*(const u32x2*)(zrow + dv)), sw = *(const f32x4*)(sub + dv);
          const f32x4 v = {o[d][4 * gq] * rs * sw[0] * g[0], o[d][4 * gq + 1] * rs * sw[1] * g[1], o[d][4 * gq + 2] * rs * sw[2] * g[2], o[d][4 * gq + 3] * rs * sw[3] * g[3]};
          *(u32x2*)(zrow + dv) = pack4(v);
        }
    }
    __syncthreads();
  }
}

DI void attn_phase(const Params& P, LAS unsigned char* lds, int l, bool last) {
  const int G = gridDim.x, bx = blockIdx.x;
  const int v = (G % 8 == 0) ? (bx % 8) * (G / 8) + bx / 8 : bx;
  const int nunits = last ? 2048 : 2304;
  for (int uid = v; uid < nunits; uid += G) {
    if (uid < 1024) attn_unit<1>(P, lds, l, 15 - (uid >> 6), (uid >> 4) & 3, uid & 15, false);
    else if (uid < 2048) { const int u = uid - 1024; attn_unit<0>(P, lds, l, 15 - (u >> 6), (u >> 5) & 1, u & 31, false); }
    else if (uid < 2176) { const int u = uid - 2048; attn_unit<1>(P, lds, l, u >> 3, (u >> 1) & 3, u & 1, true); }
    else { const int u = uid - 2176; attn_unit<0>(P, lds, l, u >> 3, (u >> 2) & 1, u & 3, true); }
  }
  const bf16_t* U = (const bf16_t*)(P.ws + WS_U);
  bf16_t* SGP = (bf16_t*)(P.ws + WS_SGP);
  const float* cw = P.convw + (size_t)l * 3 * 512;
  const int rows = last ? MLAT : MTOT;
  const int nth = G * NTHREADS;
  const int ctid = bx * NTHREADS + opaque_tid();
  const int ch = (ctid & 63) * 8;
  f32x4 cwv[3][2];
#pragma unroll
  for (int t = 0; t < 3; ++t) { cwv[t][0] = *(const f32x4*)(cw + 512 * t + ch); cwv[t][1] = *(const f32x4*)(cw + 512 * t + ch + 4); }
  for (int it = ctid; it < (rows / 8) * 64; it += nth) {
    const int r0 = (it >> 6) * 8;
    const bool lat = r0 < MLAT;
    const int s0 = lat ? (r0 & (SEQ - 1)) : ((r0 - MLAT) & (CTXL - 1)), slen = lat ? SEQ : CTXL;
    const u32x4 z = {0u, 0u, 0u, 0u};
    u32x4 uu[10], pr[8];
    uu[0] = s0 > 0 ? *(const u32x4*)(U + (size_t)(r0 - 1) * 512 + ch) : z;
#pragma unroll
    for (int i = 0; i < 8; ++i) uu[1 + i] = *(const u32x4*)(U + (size_t)(r0 + i) * 512 + ch);
    uu[9] = (s0 + 8 < slen) ? *(const u32x4*)(U + (size_t)(r0 + 8) * 512 + ch) : z;
#pragma unroll
    for (int i = 0; i < 8; ++i) pr[i] = *(const u32x4*)(SGP + (size_t)(r0 + i) * 1536 + 512 + ch);
#pragma unroll
    for (int i = 0; i < 8; ++i) {
      u32x4 res;
#pragma unroll
      for (int e = 0; e < 4; ++e) {
        const int k = (2 * e) >> 2, i0 = (2 * e) & 3;
        const float a = cwv[0][k][i0] * __uint_as_float(uu[i][e] << 16) + cwv[1][k][i0] * __uint_as_float(uu[i + 1][e] << 16) + cwv[2][k][i0] * __uint_as_float(uu[i + 2][e] << 16);
        const float bq = cwv[0][k][i0 + 1] * __uint_as_float(uu[i][e] & 0xffff0000u) + cwv[1][k][i0 + 1] * __uint_as_float(uu[i + 1][e] & 0xffff0000u) + cwv[2][k][i0 + 1] * __uint_as_float(uu[i + 2][e] & 0xffff0000u);
        res[e] = pk2(a * __uint_as_float(pr[i][e] << 16), bq * __uint_as_float(pr[i][e] & 0xffff0000u));
      }
      *(u32x4*)(SGP + (size_t)(r0 + i) * 1536 + 512 + ch) = res;
    }
  }
}

__global__ void __launch_bounds__(NTHREADS, 2) fwd_megakernel(Params P) {
  extern __shared__ __attribute__((aligned(16))) unsigned char lds_raw[];
  LAS unsigned char* lds = (LAS unsigned char*)lds_raw;
  cg::grid_group grid = cg::this_grid();
  const int G = gridDim.x;
  volatile LAS unsigned* xst = (volatile LAS unsigned*)(lds + LDS_BYTES - 64);
  if (threadIdx.x < 2) xst[threadIdx.x] = 0u;
  __syncthreads();
  const XcdBarrier xbar = xcd_barrier_post((unsigned*)(P.ws + WS_BAR), xst);
  phase0(P, lds);
  grid.sync();
#pragma unroll 1
  for (int l = 0; l < DEPTH; ++l) {
    const bool last = (l == DEPTH - 1);
    norm_phase(P, l);
    xcd_barrier(xbar);
#define MAKE_EGI(OFF) EpiGI egi{(bf16_t*)(P.ws + WS_QA), (bf16_t*)(P.ws + WS_KA), (bf16_t*)(P.ws + WS_VA), (bf16_t*)(P.ws + WS_QC), (bf16_t*)(P.ws + WS_KC), (bf16_t*)(P.ws + WS_VC), \
              (bf16_t*)(P.ws + WS_U), (bf16_t*)(P.ws + WS_SGP), (bf16_t*)(P.ws + WS_G), P.qn + l * 64, P.kn + l * 64, (const float*)(P.ws + WS_ROPE), OFF}; \
    const bf16_t* WinT = (const bf16_t*)(P.ws + WS_WIN) + (size_t)l * PROJ * 1024
    {
      MAKE_EGI(0);
      pg8::Gemm g{(const bf16_t*)(P.ws + WS_H), WinT, MTOT, GI1_TILES * 256, 1024, 16};
      OrderGI S; S.base.init(last ? MLAT : MTOT, GI1_TILES * 256, G, (int)blockIdx.x); S.extra = last ? 5 * (MCTX / 256) : 0;
      pg8::gemm_phase<EpiGI, OrderGI, true, true, false>(lds, g, S, egi);
    }
    xcd_barrier(xbar);
    attn_phase(P, lds, l, last);
    xcd_barrier(xbar);
    const int Mrows = last ? MLAT : MTOT;
    {
      MAKE_EGI(GI1_TILES);
      pg8::Gemm g{(const bf16_t*)(P.ws + WS_H), WinT + (size_t)GI1_TILES * 256 * 1024, Mrows, GI2_TILES * 256, 1024, 16};
      OrderGI S; S.base.init(Mrows, GI2_TILES * 256, G, (int)blockIdx.x); S.extra = 0;
      pg8::gemm_phase<EpiGI, OrderGI, true, true, false>(lds, g, S, egi);
    }
    xcd_barrier(xbar);
#define RUN_GM(SM) do { const EpiGM egm{(const unsigned char*)(P.ws + WS_G), (bf16_t*)(P.ws + WS_H)}; \
      const pg8::Gemm ggm{(const bf16_t*)(P.ws + WS_SGP), (const bf16_t*)(P.ws + WS_WM) + (size_t)l * 1024 * 1536, Mrows, 1024, 1536, 8}; \
      pg8::gemm_phase<EpiGM, ListOrder<true>, true, true, true>(lds, ggm, SM, egm); } while (0)
#define RUN_GO(SO) do { const EpiGO ego{l == 0 ? P.x : (const float*)P.out, l == 0 ? P.ctx : (const float*)(P.ws + WS_XC), P.out, (float*)(P.ws + WS_XC), (const float*)(P.ws + WS_MOD) + (size_t)l * 17 * 3072}; \
      const pg8::Gemm ggo{(const bf16_t*)(P.ws + WS_H), (const bf16_t*)(P.ws + WS_WO) + (size_t)l * 1024 * 1024, Mrows, 1024, 1024, 16}; \
      pg8::gemm_phase<EpiGO, ListOrder<false>, true, true, false>(lds, ggo, SO, ego); } while (0)
    {
      ListOrder<true> Sm; Sm.clear();
      pg8::StaticOrder B; B.init(Mrows, 1024, G, (int)blockIdx.x); pg8::Unit t;
      if (B.next(0, t)) { Sm.set0(t.pm, t.pn); if (B.next(1, t)) Sm.set1(t.pm, t.pn); }
      RUN_GM(Sm);
    }
    xcd_barrier(xbar);
    {
      ListOrder<true> Sm; Sm.clear();
      ListOrder<false> So; So.clear();
      pg8::StaticOrder B; B.init(Mrows, 1024, G, (int)blockIdx.x); pg8::Unit t;
      if (last) { if (B.next(0, t)) { So.set0(t.pm, t.pn); if (B.next(1, t)) So.set1(t.pm, t.pn); } }
      else if ((int)blockIdx.x < 64) { if (B.next(2, t)) Sm.set0(t.pm, t.pn); }
      else {
        const int q = ((int)blockIdx.x & 7) * 24 + (((int)blockIdx.x >> 3) - 8);
        { int pm = q >> 2;
#pragma unroll
          for (int x = 0; x < 8; ++x) if (pm >= late_base(x)) pm += 8;
          So.set0(pm, q & 3); }
        if (q + 192 < 320) { int pm = (q + 192) >> 2;
#pragma unroll
          for (int x = 0; x < 8; ++x) if (pm >= late_base(x)) pm += 8;
          So.set1(pm, (q + 192) & 3); }
      }
      RUN_GM(Sm);
      RUN_GO(So);
    }
    if (!last) {
      xcd_barrier(xbar);
      ListOrder<false> So; So.clear();
      const int q = ((int)blockIdx.x & 7) * 32 + ((int)blockIdx.x >> 3); if (q < 256) { const int k = q >> 2; So.set0(late_base(k >> 3) + (k & 7), q & 3); }
      RUN_GO(So);
    }
    xcd_barrier(xbar);
  }
  final_phase(P);
}

extern "C" void kernel_launch(void* const* d_in, const int* in_sizes, int n_in, void* d_out, int out_size, void* d_ws, size_t ws_size, hipStream_t stream) {
  static int grid_blocks = 0;
  if (grid_blocks == 0) {
    if (n_in != 20 || out_size != MLAT * DM || ws_size < WS_END) { fprintf(stderr, "kernel_launch: unexpected problem (n_in %d, out %d, ws %zu)\n", n_in, out_size, ws_size); grid_blocks = -1; return; }
    int dev = 0, cus = 0, per_cu = 0;
    hipGetDevice(&dev);
    hipDeviceGetAttribute(&cus, hipDeviceAttributeMultiprocessorCount, dev);
    hipFuncSetAttribute((const void*)fwd_megakernel, hipFuncAttributeMaxDynamicSharedMemorySize, LDS_BYTES);
    hipOccupancyMaxActiveBlocksPerMultiprocessor(&per_cu, (const void*)fwd_megakernel, NTHREADS, LDS_BYTES);
    if (per_cu < 1) per_cu = 1;
    grid_blocks = cus * per_cu;
    if (grid_blocks % 8 != 0 || grid_blocks <= 0) grid_blocks = (grid_blocks / 8) * 8;
    if (grid_blocks != 256) { fprintf(stderr, "kernel_launch: this kernel's merge/out GEMM unit lists are laid out for exactly 256 workgroups (one per CU of a 256-CU device); got %d; nothing launched\n", grid_blocks); grid_blocks = -1; return; }
    (void)hipGetLastError();
  }
  if (grid_blocks <= 0) return;
  Params p{};
  const float** pp = (const float**)&p;
  for (int i = 0; i < 20; ++i) pp[i] = (const float*)d_in[i];
  p.out = (float*)d_out; p.ws = (unsigned char*)d_ws;
  p.lam_init[0] = 0.2f; p.lam_init[1] = 0.35550907f; p.lam_init[2] = 0.47071302f; p.lam_init[3] = 0.55605821f;
  hipMemsetAsync((char*)d_ws + WS_BAR, 0, 16384, stream);
  void* args[] = {&p};
  hipError_t e = hipLaunchCooperativeKernel((const void*)fwd_megakernel, dim3(grid_blocks), dim3(NTHREADS), args, LDS_BYTES, stream);
  if (e != hipSuccess) fprintf(stderr, "cooperative launch failed: %s (grid %d)\n", hipGetErrorString(e), grid_blocks);
}
```
